# Optimizing an MI355X kernel written in HIP

```python
import jax, jax.numpy as jnp
from jax import lax
import numpy as np

D_MODEL = 1024
BATCH = 1
SEQ = 16384
DEPTH = 4
DEC_BATCH = 16
DEC_SEQ = 16
PAST_LEN = 4096

CHUNK = 64
N_EVEN = (DEPTH + 1) // 2
N_ODD = DEPTH // 2
MIX_WIDTH = D_MODEL
H_RET = 8
DK_RET = 64
DV_RET = 64
D_RET = H_RET * DK_RET
ROPE_BASE = 10000.0
D_SCONV = MIX_WIDTH - D_RET
SCONV_WIDTH = 3
POOL_WINDOWS = (2, 4, 8, 16)
N_POOL_GROUPS = 4
D_POOL = MIX_WIDTH // 2
POOL_GROUP = D_POOL // N_POOL_GROUPS
POOL_BUF = max(POOL_WINDOWS) - 1
H_ATT = 8
DH_ATT = 64
D_ATT = H_ATT * DH_ATT
N_PREV_CHUNKS = 8
REL_CLIP = 256
REL_SIZE = CHUNK + REL_CLIP
D_FF = 2816
FFN_CONV_WIDTH = 3
EPS = 1e-6
D_IN_EVEN = 4 * D_RET + 3 * D_SCONV
D_IN_ODD = D_POOL + 3 * D_ATT
NEG_INF = -1e30

kernel_name = 'hybrid_stream_encoder_step'


def rmsnorm(x, g):
    xf = x.astype(jnp.float32)
    y = xf * lax.rsqrt(jnp.mean(xf * xf, axis=-1, keepdims=True) + EPS)
    return (y * g.astype(jnp.float32)).astype(x.dtype)


def modulate(x, shift, scale):
    return x * (1 + scale[:, None, :]) + shift[:, None, :]


def causal_dwconv(u, buf, w):
    W = w.shape[0]
    T = u.shape[1]
    xc = jnp.concatenate([buf.astype(u.dtype), u], axis=1)
    y = sum(w[j] * xc[:, j:j + T] for j in range(W))
    return y, xc[:, -(W - 1):]


def rotary(x, pos):
    half = x.shape[-1] // 2
    inv = ROPE_BASE ** (-jnp.arange(half, dtype=jnp.float32) / half)
    ang = pos.astype(jnp.float32)[:, None] * inv[None, :]
    cos = jnp.cos(ang)[None, :, None, :]
    sin = jnp.sin(ang)[None, :, None, :]
    x1 = x[..., :half].astype(jnp.float32)
    x2 = x[..., half:].astype(jnp.float32)
    return jnp.concatenate([x1 * cos - x2 * sin, x1 * sin + x2 * cos], axis=-1).astype(x.dtype)


def retention_log_decay():
    return jnp.log1p(-(2.0 ** (-5.0 - jnp.arange(H_RET, dtype=jnp.float32))))


def retention_intra(q, k, v, log_g):
    T = q.shape[2]
    idx = jnp.arange(T, dtype=jnp.float32)
    diff = idx[:, None] - idx[None, :]
    dec = jnp.where(diff[None] >= 0, jnp.exp(log_g[:, None, None] * jnp.maximum(diff, 0.0)[None]), 0.0)
    s = jnp.einsum('bnthd,bnshd->bnhts', q, k) * dec[None, None]
    return jnp.einsum('bnhts,bnshe->bnthe', s, v.astype(jnp.float32))


def retention_prompt(q, k, v, log_g):
    B, T, H, dk = q.shape
    dv = v.shape[-1]
    n_chunks = T // CHUNK
    qc = q.reshape(B, n_chunks, CHUNK, H, dk)
    kc = k.reshape(B, n_chunks, CHUNK, H, dk)
    vc = v.reshape(B, n_chunks, CHUNK, H, dv)
    inner = retention_intra(qc, kc, vc, log_g)
    idx = jnp.arange(CHUNK, dtype=jnp.float32)
    zeta = jnp.exp(log_g[:, None] * (CHUNK - 1 - idx)[None, :])
    xi = jnp.exp(log_g[:, None] * (idx + 1)[None, :])
    kv = jnp.einsum('bnchd,hc,bnche->bnhde', kc.astype(jnp.float32), zeta, vc.astype(jnp.float32))
    g_chunk = jnp.exp(log_g * CHUNK)[None, :, None, None]

    def step(R, kv_n):
        return R * g_chunk + kv_n, R

    R_fin, R_prev = lax.scan(step, jnp.zeros((B, H, dk, dv), jnp.float32), jnp.moveaxis(kv, 1, 0))
    R_prev = jnp.moveaxis(R_prev, 0, 1)
    cross = jnp.einsum('bnchd,bnhde->bnche', qc.astype(jnp.float32), R_prev) * xi.T[None, None, :, :, None]
    return (inner + cross).reshape(B, T, H, dv), R_fin


def retention_step(q, k, v, S, log_g):
    T = q.shape[1]
    S = S.astype(jnp.float32)
    inner = retention_intra(q[:, None], k[:, None], v[:, None], log_g)[:, 0]
    idx = jnp.arange(T, dtype=jnp.float32)
    xi = jnp.exp(log_g[:, None] * (idx + 1)[None, :])
    zeta = jnp.exp(log_g[:, None] * (T - 1 - idx)[None, :])
    cross = jnp.einsum('bthd,bhde->bthe', q.astype(jnp.float32), S) * xi.T[None, :, :, None]
    S_new = S * jnp.exp(log_g * T)[None, :, None, None] + jnp.einsum('bthd,ht,bthe->bhde', k.astype(jnp.float32), zeta, v.astype(jnp.float32))
    return inner + cross, S_new


def retention_output(o, gain, g, dtype):
    B, T = o.shape[:2]
    mu = jnp.mean(o, axis=-1, keepdims=True)
    var = jnp.mean(jnp.square(o - mu), axis=-1, keepdims=True)
    on = ((o - mu) * lax.rsqrt(var + EPS)).reshape(B, T, D_RET) * gain.astype(jnp.float32)
    return (jax.nn.silu(g.astype(jnp.float32)) * on).astype(dtype)


def multiscale_pool(p, buf, pos, pool_w, pool_scale):
    B, T, C = p.shape
    xc = jnp.concatenate([buf.astype(p.dtype), p], axis=1).astype(jnp.float32)
    cs = jnp.concatenate([jnp.zeros((B, 1, C), jnp.float32), lax.cumsum(xc, axis=1)], axis=1)
    end = cs[:, POOL_BUF + 1:]
    cur = xc[:, POOL_BUF:]
    groups = []
    for gi, w in enumerate(POOL_WINDOWS):
        sl = slice(gi * POOL_GROUP, (gi + 1) * POOL_GROUP)
        start = cs[:, POOL_BUF + 1 - w:POOL_BUF + 1 - w + T, sl]
        cnt = jnp.minimum(pos + 1, w).astype(jnp.float32)[None, :, None]
        groups.append((end[..., sl] - start) / cnt - cur[..., sl])
    pooled = jnp.stack(groups, axis=2)
    y = jnp.einsum('btgc,gcd->btgd', pooled, pool_w.astype(jnp.float32)).reshape(B, T, C)
    y = (y * pool_scale.astype(jnp.float32)).astype(p.dtype)
    return y, xc[:, -POOL_BUF:].astype(p.dtype)


def rel_bias(table, qpos, kpos):
    rel = jnp.clip(qpos[:, None] - kpos[None, :], -(CHUNK - 1), REL_CLIP) + (CHUNK - 1)
    return table[:, rel].astype(jnp.float32)


def chunk_attention_prompt(q, k, v, table):
    B, T, H, dh = q.shape
    n_chunks = T // CHUNK
    pad = N_PREV_CHUNKS * CHUNK
    kp = jnp.pad(k, ((0, 0), (pad, 0), (0, 0), (0, 0))).reshape(B, n_chunks + N_PREV_CHUNKS, CHUNK, H, dh)
    vp = jnp.pad(v, ((0, 0), (pad, 0), (0, 0), (0, 0))).reshape(B, n_chunks + N_PREV_CHUNKS, CHUNK, H, dh)
    kb = jnp.concatenate([kp[:, j:j + n_chunks] for j in range(N_PREV_CHUNKS + 1)], axis=2)
    vb = jnp.concatenate([vp[:, j:j + n_chunks] for j in range(N_PREV_CHUNKS + 1)], axis=2)
    qc = q.reshape(B, n_chunks, CHUNK, H, dh)
    band = (N_PREV_CHUNKS + 1) * CHUNK
    qi = jnp.arange(CHUNK, dtype=jnp.int32)
    kj = jnp.arange(band, dtype=jnp.int32)
    bias = rel_bias(table, qi + pad, kj)
    valid = (jnp.arange(n_chunks, dtype=jnp.int32)[:, None] * CHUNK + kj[None, :] - pad) >= 0
    s = jnp.einsum('bnqhd,bnkhd->bnhqk', qc, kb).astype(jnp.float32) * (DH_ATT ** -0.5) + bias[None, None]
    s = jnp.where(valid[None, :, None, None, :], s, NEG_INF)
    p = jax.nn.softmax(s, axis=-1)
    o = jnp.einsum('bnhqk,bnkhd->bnqhd', p.astype(v.dtype), vb).reshape(B, T, H * dh)
    keep = min(pad, T)
    return o, k[:, -keep:], v[:, -keep:]


def chunk_attention_step(q, k, v, k_cache, v_cache, table, pos):
    B, T, H, dh = q.shape
    L = k_cache.shape[1]
    k_all = jnp.concatenate([k_cache.astype(k.dtype), k], axis=1)
    v_all = jnp.concatenate([v_cache.astype(v.dtype), v], axis=1)
    kpos = jnp.concatenate([pos[0] - L + jnp.arange(L, dtype=jnp.int32), pos])
    bias = rel_bias(table, pos, kpos)
    s = jnp.einsum('bqhd,bkhd->bhqk', q, k_all).astype(jnp.float32) * (DH_ATT ** -0.5) + bias[None]
    p = jax.nn.softmax(s, axis=-1)
    return jnp.einsum('bhqk,bkhd->bqhd', p.astype(v.dtype), v_all).reshape(B, T, H * dh)


def even_mixer(h, pos, S, sconv_buf, w_in, w_out, gn_gain, conv_w):
    B, T, _ = h.shape
    proj = h @ w_in
    splits = [D_RET, 2 * D_RET, 3 * D_RET, 4 * D_RET, 4 * D_RET + D_SCONV, 4 * D_RET + 2 * D_SCONV]
    q, k, v, g, gate_b, gate_c, hv = jnp.split(proj, splits, axis=-1)
    q = rotary(q.reshape(B, T, H_RET, DK_RET), pos)
    k = rotary(k.reshape(B, T, H_RET, DK_RET), pos) * (DK_RET ** -0.5)
    v = v.reshape(B, T, H_RET, DV_RET)
    log_g = retention_log_decay()
    if S is None:
        o, S_new = retention_prompt(q, k, v, log_g)
    else:
        o, S_new = retention_step(q, k, v, S, log_g)
    ret_out = retention_output(o, gn_gain, g, h.dtype)
    conv_y, sconv_new = causal_dwconv(gate_c * hv, sconv_buf, conv_w)
    out = jnp.concatenate([ret_out, gate_b * conv_y], axis=-1) @ w_out
    return out, S_new, sconv_new


def odd_mixer(h, pos, pool_buf, k_cache, v_cache, w_in, w_out, pool_w, pool_scale, table):
    B, T, _ = h.shape
    proj = h @ w_in
    p, q, k, v = jnp.split(proj, [D_POOL, D_POOL + D_ATT, D_POOL + 2 * D_ATT], axis=-1)
    pool_out, pool_new = multiscale_pool(p, pool_buf, pos, pool_w, pool_scale)
    q = q.reshape(B, T, H_ATT, DH_ATT)
    k = k.reshape(B, T, H_ATT, DH_ATT)
    v = v.reshape(B, T, H_ATT, DH_ATT)
    if k_cache is None:
        att, k_new, v_new = chunk_attention_prompt(q, k, v, table)
    else:
        att = chunk_attention_step(q, k, v, k_cache, v_cache, table, pos)
        k_new, v_new = k, v
    out = jnp.concatenate([pool_out, att], axis=-1) @ w_out
    return out, pool_new, k_new, v_new


def conv_ffn(h, buf, w_up, conv_w, w_down):
    up = h @ w_up
    upc, buf_new = causal_dwconv(up, buf, conv_w)
    a, b = jnp.split(upc, 2, axis=-1)
    return (jax.nn.silu(a) * b) @ w_down, buf_new


def run_trunk(x, c, pos, cache, weights):
    (norm_mix, norm_ffn, norm_final, w_ada, b_ada, w_in_even, w_out_even, ret_gn_gain, sconv_w,
     w_in_odd, w_out_odd, pool_w, pool_scale, rel_bias_table, ffn_w_up, ffn_conv, ffn_w_down) = weights
    B = x.shape[0]
    mod = jnp.einsum('bd,lde->lbe', jax.nn.silu(c), w_ada) + b_ada[:, None, :]
    new_ret, new_sconv, new_pool, new_k, new_v, new_ffn = [], [], [], [], [], []
    for l in range(DEPTH):
        sh_m, sc_m, g_m, sh_f, sc_f, g_f = jnp.split(mod[l], 6, axis=-1)
        hm = modulate(rmsnorm(x, norm_mix[l]), sh_m, sc_m)
        i = l // 2
        if l % 2 == 0:
            if cache is None:
                S, sbuf = None, jnp.zeros((B, SCONV_WIDTH - 1, D_SCONV), x.dtype)
            else:
                S, sbuf = cache[0][i], cache[1][i]
            y, S_new, sbuf_new = even_mixer(hm, pos, S, sbuf, w_in_even[i], w_out_even[i], ret_gn_gain[i], sconv_w[i])
            new_ret.append(S_new)
            new_sconv.append(sbuf_new)
        else:
            if cache is None:
                pbuf, kc, vc = jnp.zeros((B, POOL_BUF, D_POOL), x.dtype), None, None
            else:
                pbuf, kc, vc = cache[2][i], cache[3][i], cache[4][i]
            y, pbuf_new, k_new, v_new = odd_mixer(hm, pos, pbuf, kc, vc, w_in_odd[i], w_out_odd[i], pool_w[i], pool_scale[i], rel_bias_table[i])
            new_pool.append(pbuf_new)
            new_k.append(k_new)
            new_v.append(v_new)
        x = x + g_m[:, None, :] * y
        hf = modulate(rmsnorm(x, norm_ffn[l]), sh_f, sc_f)
        fbuf = jnp.zeros((B, FFN_CONV_WIDTH - 1, 2 * D_FF), x.dtype) if cache is None else cache[5][l]
        y, fbuf_new = conv_ffn(hf, fbuf, ffn_w_up[l], ffn_conv[l], ffn_w_down[l])
        new_ffn.append(fbuf_new)
        x = x + g_f[:, None, :] * y
    return (rmsnorm(x, norm_final), jnp.stack(new_ret), jnp.stack(new_sconv), jnp.stack(new_pool),
            jnp.stack(new_k), jnp.stack(new_v), jnp.stack(new_ffn))


def setup_inputs(seed: int = 0) -> dict:
    key = jax.random.key(seed)
    ks = jax.random.split(key, 27)
    f32 = jnp.float32

    def nrm(i, shape, s):
        return jax.random.normal(ks[i], shape, f32) * s

    att_cache = min(N_PREV_CHUNKS * CHUNK, PAST_LEN)
    return {
        'x_prompt': nrm(0, (BATCH, SEQ, D_MODEL), 1.0),
        'x_sample': nrm(1, (DEC_BATCH, DEC_SEQ, D_MODEL), 1.0),
        'state_ret': nrm(2, (N_EVEN, DEC_BATCH, H_RET, DK_RET, DV_RET), 1.0),
        'state_sconv': nrm(3, (N_EVEN, DEC_BATCH, SCONV_WIDTH - 1, D_SCONV), 1.0),
        'state_pool': nrm(4, (N_ODD, DEC_BATCH, POOL_BUF, D_POOL), 1.0),
        'cache_k': nrm(5, (N_ODD, DEC_BATCH, att_cache, H_ATT, DH_ATT), 1.0),
        'cache_v': nrm(6, (N_ODD, DEC_BATCH, att_cache, H_ATT, DH_ATT), 1.0),
        'state_ffn': nrm(7, (DEPTH, DEC_BATCH, FFN_CONV_WIDTH - 1, 2 * D_FF), 1.0),
        'c_prompt': nrm(8, (BATCH, D_MODEL), 1.0),
        'c_sample': nrm(9, (DEC_BATCH, D_MODEL), 1.0),
        'norm_mix': 1.0 + nrm(10, (DEPTH, D_MODEL), 0.02),
        'norm_ffn': 1.0 + nrm(11, (DEPTH, D_MODEL), 0.02),
        'norm_final': 1.0 + nrm(12, (D_MODEL,), 0.02),
        'w_ada': nrm(13, (DEPTH, D_MODEL, 6 * D_MODEL), 0.5 * D_MODEL ** -0.5),
        'b_ada': nrm(14, (DEPTH, 6 * D_MODEL), 0.01),
        'w_in_even': nrm(15, (N_EVEN, D_MODEL, D_IN_EVEN), D_MODEL ** -0.5),
        'w_out_even': nrm(16, (N_EVEN, MIX_WIDTH, D_MODEL), MIX_WIDTH ** -0.5),
        'ret_gn_gain': 1.0 + nrm(17, (N_EVEN, D_RET), 0.02),
        'sconv_w': nrm(18, (N_EVEN, SCONV_WIDTH, D_SCONV), SCONV_WIDTH ** -0.5),
        'w_in_odd': nrm(19, (N_ODD, D_MODEL, D_IN_ODD), D_MODEL ** -0.5),
        'w_out_odd': nrm(20, (N_ODD, MIX_WIDTH, D_MODEL), MIX_WIDTH ** -0.5),
        'pool_w': nrm(21, (N_ODD, N_POOL_GROUPS, POOL_GROUP, POOL_GROUP), POOL_GROUP ** -0.5),
        'pool_scale': 1.0 + nrm(22, (N_ODD, D_POOL), 0.1),
        'rel_bias_table': nrm(23, (N_ODD, H_ATT, REL_SIZE), 0.5),
        'ffn_w_up': nrm(24, (DEPTH, D_MODEL, 2 * D_FF), D_MODEL ** -0.5),
        'ffn_conv': nrm(25, (DEPTH, FFN_CONV_WIDTH, 2 * D_FF), FFN_CONV_WIDTH ** -0.5),
        'ffn_w_down': nrm(26, (DEPTH, D_FF, D_MODEL), D_FF ** -0.5),
    }


def reference(x_prompt, x_sample, state_ret, state_sconv, state_pool, cache_k, cache_v, state_ffn,
              c_prompt, c_sample, norm_mix, norm_ffn, norm_final, w_ada, b_ada, w_in_even, w_out_even,
              ret_gn_gain, sconv_w, w_in_odd, w_out_odd, pool_w, pool_scale, rel_bias_table,
              ffn_w_up, ffn_conv, ffn_w_down):
    weights = (norm_mix, norm_ffn, norm_final, w_ada, b_ada, w_in_even, w_out_even, ret_gn_gain, sconv_w,
               w_in_odd, w_out_odd, pool_w, pool_scale, rel_bias_table, ffn_w_up, ffn_conv, ffn_w_down)
    pos_p = jnp.arange(x_prompt.shape[1], dtype=jnp.int32)
    y_prompt, ret_p, sconv_p, pool_p, k_p, v_p, ffn_p = run_trunk(x_prompt, c_prompt, pos_p, None, weights)
    pos_s = PAST_LEN + jnp.arange(x_sample.shape[1], dtype=jnp.int32)
    cache = (state_ret, state_sconv, state_pool, cache_k, cache_v, state_ffn)
    y_sample, ret_s, sconv_s, pool_s, k_s, v_s, ffn_s = run_trunk(x_sample, c_sample, pos_s, cache, weights)
    return (y_prompt, y_sample, ret_p, ret_s, sconv_p, sconv_s, pool_p, pool_s, k_p, k_s, v_p, v_s, ffn_p, ffn_s)
```

```cpp
#include <hip/hip_runtime.h>
#include <hip/hip_cooperative_groups.h>
#include <cstdio>
#include <cstdint>
namespace cg = cooperative_groups;
namespace pg8 {
#define PG8_LAS __attribute__((address_space(3)))
typedef unsigned short bf16_t;
typedef short bf16x8 __attribute__((ext_vector_type(8)));
typedef float f32x4 __attribute__((ext_vector_type(4)));
typedef unsigned u32x4 __attribute__((ext_vector_type(4)));
constexpr int BM = 256, BK = 64, HALF = 128, HTB = HALF * BK * 2  , STAGE_BYTES = 8 * HTB, NXCD = 8, WGM = 4;

__host__ __device__ __forceinline__ int lds_byte(int r, int c) { const int st = (r >> 4) * 2 + (c >> 5), rr = r & 15, cc = c & 31, ob = rr * 64 + cc * 2; return st * 1024 + (ob ^ (((ob >> 9) & 1) << 5)); }
__host__ __device__ __forceinline__ void stage_rc(int b, int& R, int& C) { const int st = b / 1024, sb = b % 1024, swz = sb ^ (((sb >> 9) & 1) << 5); R = (st >> 1) * 16 + swz / 64; C = (st & 1) * 32 + (swz % 64) / 2; }
__host__ __device__ __forceinline__ int perm32(int rho) { const int n = rho >> 4, i = rho & 15; return 8 * (i >> 2) + 4 * n + (i & 3); }

struct Unit { int pm, pn; };
struct Gemm { const bf16_t* A; const bf16_t* Bt; int M, N, K; };

struct StaticOrder {
    int nM, nN, nwg, G, c;
    __host__ __device__ void init(int M, int N, int G_, int c_) { nM = M / BM; nN = N / BM; nwg = nM * nN; G = G_; c = c_; }
    __host__ __device__ bool next(int i, Unit& u) const {
        const long L = (long)i * G + c; if (L >= nwg) return false;
        int wgid = (int)L; { const int q = nwg / NXCD, r = nwg % NXCD, xcd = wgid % NXCD, off = wgid / NXCD; wgid = (xcd < r ? xcd * (q + 1) : r * (q + 1) + (xcd - r) * q) + off; }
        const int nig = WGM * nN, gid = wgid / nig, fm = gid * WGM, gsz = (nM - fm) < WGM ? (nM - fm) : WGM;
        u.pm = fm + ((wgid % nig) % gsz); u.pn = (wgid % nig) / gsz; return true;
    }
    __device__ __forceinline__ void a_ready(const Unit&) const {}
    __device__ __forceinline__ void done(const Unit&) const {}
};

__device__ __forceinline__ unsigned cvt_pk_bf16(float lo, float hi) { unsigned r; asm volatile("v_cvt_pk_bf16_f32 %0, %1, %2" : "=v"(r) : "v"(lo), "v"(hi)); return r; }
template <class Epi, class Sched, bool ALIGN_EPI = false, bool SP2 = false>
__device__ __forceinline__ void gemm_phase(PG8_LAS unsigned char* lds, const Gemm g, const Sched& S, const Epi& E) {
    int tid; asm volatile("v_mov_b32 %0, %1" : "=v"(tid) : "v"((int)threadIdx.x));
    const int wid = __builtin_amdgcn_readfirstlane(tid >> 6), lane = tid & 63, wr = wid >> 2, wc = wid & 3, fr = lane & 15, fq = lane >> 4;
    const int K = g.K, nt = K / BK;
    unsigned voffA[2], voffB[2];
#pragma unroll
    for (int i = 0; i < 2; ++i) { int R, C; stage_rc(tid * 16 + i * 8192, R, C); const int Rb = Epi::PERM ? ((R & ~31) + perm32(R & 31)) : R;
        voffA[i] = (unsigned)(R * K + C) * 2u; voffB[i] = (unsigned)(Rb * K + C) * 2u; }
    const size_t kstep = (size_t)(BK * 2);
    const size_t hstep = (size_t)HALF * K * 2;
    const size_t tstep = 2 * hstep;
    const unsigned ldsw = (unsigned)wid * 1024u;
    const int aoff = lds_byte(wr * 64 + fr, fq * 8), boff = lds_byte(wc * 32 + fr, fq * 8);
#define PG8_SA(b, h) (((b) * 2 + (h)) * HTB)
#define PG8_SB(b, h) ((4 + (b) * 2 + (h)) * HTB)
#define PG8_STAGE(bufoff, gbase, voff) do { _Pragma("unroll") for (int _i = 0; _i < 2; ++_i) \
        __builtin_amdgcn_global_load_lds((const unsigned*)((const char*)(gbase) + (voff)[_i]), (PG8_LAS unsigned*)(lds + (bufoff) + ldsw + _i * 8192), 16, 0, 0); } while (0)
#define PG8_LDA(dst, b, h) do { _Pragma("unroll") for (int m = 0; m < 4; ++m) _Pragma("unroll") for (int k = 0; k < 2; ++k) dst[m][k] = *(const PG8_LAS bf16x8*)(lds + PG8_SA(b, h) + aoff + m * 2048 + k * 1024); } while (0)
#define PG8_LDB(dst, b, h) do { _Pragma("unroll") for (int n = 0; n < 2; ++n) _Pragma("unroll") for (int k = 0; k < 2; ++k) dst[n][k] = *(const PG8_LAS bf16x8*)(lds + PG8_SB(b, h) + boff + n * 2048 + k * 1024); } while (0)
#define PG8_MMA(ai, bj, At, Bt) do { __builtin_amdgcn_s_setprio(1); _Pragma("unroll") for (int m = 0; m < 4; ++m) _Pragma("unroll") for (int n = 0; n < 2; ++n) _Pragma("unroll") for (int k = 0; k < 2; ++k) \
        acc[ai][bj][m][n] = __builtin_amdgcn_mfma_f32_16x16x32_bf16(Bt[n][k], At[m][k], acc[ai][bj][m][n], 0, 0, 0); __builtin_amdgcn_s_setprio(0); } while (0)
#define PG8_WAIT_V(n) asm volatile("s_waitcnt vmcnt(" #n ")" ::: "memory")
#define PG8_WAIT_L(n) asm volatile("s_waitcnt lgkmcnt(" #n ")" ::: "memory")
#define PG8_BAR __builtin_amdgcn_s_barrier()
#define PG8_SCHED __builtin_amdgcn_sched_barrier(0)
    Unit cur, nxt; int ui = 0;
    if (!S.next(0, cur)) return;
    f32x4 acc[2][2][4][2];
#pragma unroll
    for (int a = 0; a < 2; ++a)
#pragma unroll
        for (int b = 0; b < 2; ++b)
#pragma unroll
            for (int m = 0; m < 4; ++m)
#pragma unroll
                for (int n = 0; n < 2; ++n) acc[a][b][m][n] = (f32x4){0.f, 0.f, 0.f, 0.f};
    bf16x8 At[4][2], B0[2][2], B1[2][2];
    const char* cA = (const char*)g.A + (size_t)cur.pm * tstep; const char* cB = (const char*)g.Bt + (size_t)cur.pn * tstep;
    S.a_ready(cur);
    if constexpr (SP2) {
        PG8_STAGE(PG8_SB(0, 0), cB, voffB); PG8_STAGE(PG8_SB(0, 1), cB + hstep, voffB); PG8_STAGE(PG8_SA(0, 0), cA, voffA); PG8_STAGE(PG8_SA(0, 1), cA + hstep, voffA);
        if (wr == 1) PG8_BAR;
        PG8_WAIT_V(2); PG8_BAR;
        PG8_STAGE(PG8_SB(1, 0), cB + kstep, voffB); PG8_STAGE(PG8_SA(1, 0), cA + kstep, voffA); PG8_STAGE(PG8_SB(1, 1), cB + hstep + kstep, voffB);
        PG8_WAIT_V(6); PG8_BAR;
    } else {
        PG8_STAGE(PG8_SB(0, 0), cB, voffB); PG8_STAGE(PG8_SA(0, 0), cA, voffA); PG8_STAGE(PG8_SB(0, 1), cB + hstep, voffB); PG8_STAGE(PG8_SA(0, 1), cA + hstep, voffA);
        if (wr == 1) PG8_BAR;
        PG8_WAIT_V(4); PG8_BAR;
        PG8_STAGE(PG8_SB(1, 0), cB + kstep, voffB); PG8_STAGE(PG8_SA(1, 0), cA + kstep, voffA); PG8_STAGE(PG8_SB(1, 1), cB + hstep + kstep, voffB);
        PG8_WAIT_V(6); PG8_BAR;
    }
    for (;;) {
        const bool has_next = S.next(ui + 1, nxt);
        const char* nA = has_next ? (const char*)g.A + (size_t)nxt.pm * tstep : cA; const char* nB = has_next ? (const char*)g.Bt + (size_t)nxt.pn * tstep : cB;
        for (int t = 0; t < nt; t += 2) {
            const bool last = (t == nt - 2);
            const char* a1 = cA + (size_t)(t + 1) * kstep;
            const char* a2 = last ? nA : cA + (size_t)(t + 2) * kstep; const char* b2 = last ? nB : cB + (size_t)(t + 2) * kstep;
            const char* a3 = a2 + kstep; const char* b3 = b2 + kstep;
            if (last && has_next) S.a_ready(nxt);
            if constexpr (SP2) {
            PG8_LDB(B0, 0, 0); PG8_LDB(B1, 0, 1); PG8_SCHED; PG8_LDA(At, 0, 0); PG8_STAGE(PG8_SA(1, 1), a1 + hstep, voffA);
            PG8_WAIT_V(8); PG8_WAIT_L(0); PG8_BAR; PG8_MMA(0, 0, At, B0); PG8_MMA(0, 1, At, B1); PG8_BAR; PG8_SCHED;
            PG8_LDA(At, 0, 1); PG8_STAGE(PG8_SB(0, 0), b2, voffB); PG8_STAGE(PG8_SB(0, 1), b2 + hstep, voffB); PG8_STAGE(PG8_SA(0, 0), a2, voffA);
            PG8_WAIT_V(8); PG8_WAIT_L(0); PG8_BAR; PG8_MMA(1, 0, At, B0); PG8_MMA(1, 1, At, B1); PG8_BAR; PG8_SCHED;
            PG8_LDB(B0, 1, 0); PG8_LDB(B1, 1, 1); PG8_SCHED; PG8_LDA(At, 1, 0); PG8_STAGE(PG8_SA(0, 1), a2 + hstep, voffA);
            PG8_WAIT_V(8); PG8_WAIT_L(0); PG8_BAR; PG8_MMA(0, 0, At, B0); PG8_MMA(0, 1, At, B1); PG8_BAR; PG8_SCHED;
            PG8_LDA(At, 1, 1); PG8_STAGE(PG8_SB(1, 0), b3, voffB); PG8_STAGE(PG8_SB(1, 1), b3 + hstep, voffB); PG8_STAGE(PG8_SA(1, 0), a3, voffA);
            PG8_WAIT_V(8); PG8_WAIT_L(0); PG8_BAR; PG8_MMA(1, 0, At, B0); PG8_MMA(1, 1, At, B1); PG8_BAR; PG8_SCHED;
            } else {
            PG8_LDB(B0, 0, 0); PG8_SCHED; PG8_LDA(At, 0, 0); PG8_STAGE(PG8_SA(1, 1), a1 + hstep, voffA);
            PG8_WAIT_L(8); PG8_BAR; PG8_WAIT_L(0); PG8_MMA(0, 0, At, B0); PG8_BAR; PG8_SCHED;
            PG8_LDB(B1, 0, 1); PG8_STAGE(PG8_SB(0, 0), b2, voffB);
            PG8_BAR; PG8_WAIT_L(0); PG8_MMA(0, 1, At, B1); PG8_BAR;
            PG8_LDA(At, 0, 1); PG8_STAGE(PG8_SA(0, 0), a2, voffA);
            PG8_BAR; PG8_WAIT_L(0); PG8_MMA(1, 0, At, B0); PG8_BAR; PG8_SCHED;
            PG8_STAGE(PG8_SB(0, 1), b2 + hstep, voffB);
            PG8_WAIT_V(6); PG8_BAR; PG8_MMA(1, 1, At, B1); PG8_BAR;
            PG8_LDB(B0, 1, 0); PG8_SCHED; PG8_LDA(At, 1, 0); PG8_STAGE(PG8_SA(0, 1), a2 + hstep, voffA);
            PG8_WAIT_L(8); PG8_BAR; PG8_WAIT_L(0); PG8_MMA(0, 0, At, B0); PG8_BAR; PG8_SCHED;
            PG8_LDB(B1, 1, 1); PG8_STAGE(PG8_SB(1, 0), b3, voffB);
            PG8_BAR; PG8_WAIT_L(0); PG8_MMA(0, 1, At, B1); PG8_BAR;
            PG8_LDA(At, 1, 1); PG8_STAGE(PG8_SA(1, 0), a3, voffA);
            PG8_BAR; PG8_WAIT_L(0); PG8_MMA(1, 0, At, B0); PG8_BAR; PG8_SCHED;
            PG8_STAGE(PG8_SB(1, 1), b3 + hstep, voffB);
            PG8_WAIT_V(6); PG8_BAR; PG8_MMA(1, 1, At, B1); PG8_BAR;
            }
        }
        if constexpr (ALIGN_EPI) { if (wr == 0) PG8_BAR; }
        if constexpr (!Epi::AFTER_DRAIN) { E(acc, cur, wr, wc, fr, fq); S.done(cur); }
        if (!has_next) break;
#pragma unroll
        for (int a = 0; a < 2; ++a)
#pragma unroll
            for (int b = 0; b < 2; ++b)
#pragma unroll
                for (int m = 0; m < 4; ++m)
#pragma unroll
                    for (int n = 0; n < 2; ++n) acc[a][b][m][n] = (f32x4){0.f, 0.f, 0.f, 0.f};
        cur = nxt; cA = nA; cB = nB; ++ui;
        if constexpr (ALIGN_EPI) { if (wr == 1) PG8_BAR; }
    }
    PG8_WAIT_V(0);
    if constexpr (!ALIGN_EPI) { if (wr == 0) PG8_BAR; }
    PG8_BAR;
    if constexpr (Epi::AFTER_DRAIN) { E.fused(acc, cur, wr, wc, fr, fq, lds, wid, lane); S.done(cur); }
#undef PG8_SA
#undef PG8_SB
#undef PG8_STAGE
#undef PG8_LDA
#undef PG8_LDB
#undef PG8_MMA
#undef PG8_WAIT_V
#undef PG8_WAIT_L
#undef PG8_BAR
#undef PG8_SCHED
}
}

#define LAS __attribute__((address_space(3)))
typedef unsigned short bf16;
typedef short bf16x8 __attribute__((ext_vector_type(8)));
typedef float f32x4 __attribute__((ext_vector_type(4)));
typedef float f32x2 __attribute__((ext_vector_type(2)));
typedef unsigned u32x2 __attribute__((ext_vector_type(2)));
typedef unsigned u32x4 __attribute__((ext_vector_type(4)));

constexpr int D = 1024, SEQ = 16384, NB = 16, TS = 16, MS = NB * TS, M = SEQ + MS, NBT = 17;
constexpr int DINE = 3584, DINO = 2048, DFF = 2816, DUP = 5632, MODW = 6144;
constexpr int NWAVES = 8, NTHR = 512;
constexpr int LDS_BYTES = 147456;

constexpr size_t O_Y = 0, O_YS = (size_t)SEQ * D, O_RETP = O_YS + (size_t)MS * D, O_RETS = O_RETP + 2 * 8 * 64 * 64,
    O_SCP = O_RETS + 2 * 16 * 8 * 64 * 64, O_SCS = O_SCP + 2 * 2 * 512, O_POOLP = O_SCS + 2 * 16 * 2 * 512, O_POOLS = O_POOLP + 2 * 15 * 512,
    O_KP = O_POOLS + 2 * 16 * 15 * 512, O_KS = O_KP + 2 * 512 * 512, O_VP = O_KS + 2 * 16 * 16 * 512, O_VS = O_VP + 2 * 512 * 512,
    O_FFNP = O_VS + 2 * 16 * 16 * 512, O_FFNS = O_FFNP + 4 * 2 * DUP, O_END = O_FFNS + 4 * 16 * 2 * DUP;
static_assert(O_END == 20788224, "d_out size");

constexpr size_t WS_CTL = 0, WS_WINE = 16384, WS_WOUTE = WS_WINE + (size_t)2 * DINE * D * 2, WS_WINO = WS_WOUTE + (size_t)2 * D * D * 2, WS_WOUTO = WS_WINO + (size_t)2 * DINO * D * 2,
    WS_WUP = WS_WOUTO + (size_t)2 * D * D * 2, WS_WDN = WS_WUP + (size_t)4 * DUP * D * 2, WS_POOLW = WS_WDN + (size_t)4 * D * DFF * 2, WS_MOD = WS_POOLW + (size_t)8 * 128 * 128 * 2,
    WS_ROPE = WS_MOD + (size_t)4 * NBT * MODW * 4, WS_HM = WS_ROPE + (size_t)(SEQ + 16) * 32 * 8, WS_MIX = WS_HM + (size_t)M * D * 2, WS_EXTRA = WS_MIX + (size_t)M * D * 2,
    WS_R1 = WS_HM + (size_t)M * DFF * 2, WS_KVS = WS_R1 + (size_t)M * DINE * 2, WS_END = WS_R1 + (size_t)M * DUP * 2;
static_assert(WS_KVS + (size_t)256 * 8 * 64 * 64 * 4 <= WS_END, "kvs fits");
static_assert(WS_HM % 256 == 0 && WS_R1 % 256 == 0 && WS_ROPE % 256 == 0 && WS_MOD % 256 == 0, "align");

struct Params { const float* in[27]; float* out; unsigned char* ws; };
enum { I_XP = 0, I_XS, I_SRET, I_SSCONV, I_SPOOL, I_CK, I_CV, I_SFFN, I_CP, I_CS, I_NMIX, I_NFFN, I_NFIN, I_WADA, I_BADA, I_WINE, I_WOUTE, I_GN, I_SCW,
       I_WINO, I_WOUTO, I_POOLW, I_POOLS, I_REL, I_WUP, I_FCONV, I_WDN };

__device__ __forceinline__ unsigned pk2(float lo, float hi) { return pg8::cvt_pk_bf16(lo, hi); }
__device__ __forceinline__ bf16 f2bf(float f) { return (bf16)(pk2(f, 0.f) & 0xffffu); }
__device__ __forceinline__ float bf2f(bf16 v) { return __uint_as_float(((unsigned)v) << 16); }
__device__ __forceinline__ float bflo(unsigned w) { return __uint_as_float(w << 16); }
__device__ __forceinline__ float bfhi(unsigned w) { return __uint_as_float(w & 0xffff0000u); }
template <int CTRL> __device__ __forceinline__ float dpp_f(float x) { return __builtin_bit_cast(float, __builtin_amdgcn_mov_dpp(__builtin_bit_cast(int, x), CTRL, 0xf, 0xf, true)); }
__device__ __forceinline__ float xrow16_max(float x) {
    auto s = __builtin_amdgcn_permlane16_swap(__float_as_uint(x), __float_as_uint(x), false, false);
    x = fmaxf(__uint_as_float(s[0]), __uint_as_float(s[1]));
    auto t = __builtin_amdgcn_permlane32_swap(__float_as_uint(x), __float_as_uint(x), false, false);
    return fmaxf(__uint_as_float(t[0]), __uint_as_float(t[1]));
}
__device__ __forceinline__ float xrow16_sum(float x) {
    auto s = __builtin_amdgcn_permlane16_swap(__float_as_uint(x), __float_as_uint(x), false, false);
    x = __uint_as_float(s[0]) + __uint_as_float(s[1]);
    auto t = __builtin_amdgcn_permlane32_swap(__float_as_uint(x), __float_as_uint(x), false, false);
    return __uint_as_float(t[0]) + __uint_as_float(t[1]);
}
__device__ __forceinline__ float wave_sum(float v) {
    v += dpp_f<0xB1>(v); v += dpp_f<0x4E>(v); v += dpp_f<0x124>(v); v += dpp_f<0x128>(v);
    return xrow16_sum(v);
}
__device__ __forceinline__ float silu_f(float a) { return a * __builtin_amdgcn_rcpf(1.0f + __builtin_amdgcn_exp2f(-1.4426950408889634f * a)); }
__device__ __forceinline__ float log2_gamma(int h) {
    return h < 4 ? (h < 2 ? (h == 0 ? -0.04580368961312479f : -0.02272007650008353f) : (h == 2 ? -0.011315313227834146f : -0.005646563141142063f))
                 : (h < 6 ? (h == 4 ? -0.0028205190623786626f : -0.0014095702546713536f) : (h == 6 ? -0.0007046129765893727f : -0.0003522634716290214f)); }
__device__ __forceinline__ float fexp2(float x) { return __builtin_amdgcn_exp2f(x); }
#define LDS_WAIT() asm volatile("s_waitcnt lgkmcnt(0)" ::: "memory")
__device__ __forceinline__ int fresh_tid() { int t; asm volatile("v_mov_b32 %0, %1" : "=v"(t) : "v"((int)threadIdx.x)); return t; }
#define PHASE_IDS const int tid = fresh_tid(), lane = tid & 63, wave = __builtin_amdgcn_readfirstlane(tid >> 6); const int gw = bx * NWAVES + wave, gtid = bx * NTHR + tid; (void)lane; (void)gw; (void)gtid;

template <int NT, int KS>
__device__ __forceinline__ void wave_mm(f32x4 (&acc)[NT], const LAS bf16* a, int lda, const LAS bf16* b, int ldb, int lane) {
    const int fr = lane & 15, fq = lane >> 4;
#pragma unroll
    for (int ks = 0; ks < KS; ++ks) {
        const bf16x8 af = *(const LAS bf16x8*)(a + fr * lda + ks * 32 + fq * 8);
#pragma unroll
        for (int nt = 0; nt < NT; ++nt) {
            const bf16x8 bfr = *(const LAS bf16x8*)(b + (nt * 16 + fr) * ldb + ks * 32 + fq * 8);
            acc[nt] = __builtin_amdgcn_mfma_f32_16x16x32_bf16(bfr, af, acc[nt], 0, 0, 0);
        }
    }
}

struct EpiBf {
    static constexpr bool PERM = true, AFTER_DRAIN = false;
    bf16* O; int ldc; int mode; int li; float* out;
    __device__ __forceinline__ void operator()(const f32x4 (&acc)[2][2][4][2], const pg8::Unit& u, int wr, int wc, int fr, int fq) const {
#pragma unroll
        for (int ai = 0; ai < 2; ++ai)
#pragma unroll
            for (int m = 0; m < 4; ++m) {
                const int r = u.pm * 256 + ai * 128 + wr * 64 + m * 16 + fr;
                bf16* rowp = O + (size_t)r * ldc;
#pragma unroll
                for (int bj = 0; bj < 2; ++bj) {
                    const int c = u.pn * 256 + bj * 128 + wc * 32 + 8 * fq;
                    const f32x4 v0 = acc[ai][bj][m][0], v1 = acc[ai][bj][m][1];
                    u32x4 w; w.x = pk2(v0[0], v0[1]); w.y = pk2(v0[2], v0[3]); w.z = pk2(v1[0], v1[1]); w.w = pk2(v1[2], v1[3]);
                    *(u32x4*)(rowp + c) = w;
                }
            }
        if (mode == 1 && u.pm >= 62 && (u.pn < 2 || u.pn >= 4)) {
#pragma unroll
            for (int ai = 0; ai < 2; ++ai)
#pragma unroll
                for (int m = 0; m < 4; ++m) {
                    const int r = u.pm * 256 + ai * 128 + wr * 64 + m * 16 + fr;
                    float* dst = nullptr;
                    if (u.pn < 2) {
                        if (r < SEQ) { if (r >= SEQ - 15) dst = out + O_POOLP + ((size_t)li * 15 + (r - (SEQ - 15))) * 512; }
                        else { const int b = (r - SEQ) >> 4, t = (r - SEQ) & 15; if (t >= 1) dst = out + O_POOLS + (((size_t)li * 16 + b) * 15 + (t - 1)) * 512; }
                        if (dst) dst += u.pn * 256;
                    } else {
                        const bool isv = u.pn >= 6;
                        if (r < SEQ) dst = out + (isv ? O_VP : O_KP) + ((size_t)li * 512 + (r - (SEQ - 512))) * 512;
                        else { const int b = (r - SEQ) >> 4, t = (r - SEQ) & 15; dst = out + (isv ? O_VS : O_KS) + (((size_t)li * 16 + b) * 16 + t) * 512; }
                        dst += (u.pn & 1) * 256;
                    }
                    if (dst) {
#pragma unroll
                        for (int bj = 0; bj < 2; ++bj)
#pragma unroll
                            for (int n = 0; n < 2; ++n) *(f32x4*)(dst + bj * 128 + wc * 32 + 8 * fq + 4 * n) = acc[ai][bj][m][n];
                    }
                }
        }
        if (mode == 2 && u.pm >= 63) {
#pragma unroll
            for (int ai = 0; ai < 2; ++ai)
#pragma unroll
                for (int m = 0; m < 4; ++m) {
                    const int r = u.pm * 256 + ai * 128 + wr * 64 + m * 16 + fr;
                    float* dst = nullptr;
                    if (r < SEQ) { if (r >= SEQ - 2) dst = out + O_FFNP + ((size_t)li * 2 + (r - (SEQ - 2))) * DUP; }
                    else { const int b = (r - SEQ) >> 4, t = (r - SEQ) & 15; if (t >= 14) dst = out + O_FFNS + (((size_t)li * 16 + b) * 2 + (t - 14)) * DUP; }
                    if (dst) {
                        dst += u.pn * 256;
#pragma unroll
                        for (int bj = 0; bj < 2; ++bj)
#pragma unroll
                            for (int n = 0; n < 2; ++n) *(f32x4*)(dst + bj * 128 + wc * 32 + 8 * fq + 4 * n) = acc[ai][bj][m][n];
                    }
                }
        }
    }
};
struct EpiRes {
    static constexpr bool PERM = false, AFTER_DRAIN = false;
    const float* base_p; const float* base_s; float* out; const float* gate;
    __device__ __forceinline__ void operator()(const f32x4 (&acc)[2][2][4][2], const pg8::Unit& u, int wr, int wc, int fr, int fq) const {
#pragma unroll
        for (int ai = 0; ai < 2; ++ai)
#pragma unroll
            for (int m = 0; m < 4; ++m) {
                const int r = u.pm * 256 + ai * 128 + wr * 64 + m * 16 + fr;
                const int b = r < SEQ ? 0 : 1 + ((r - SEQ) >> 4);
                const float* bp = r < SEQ ? base_p + (size_t)r * D : base_s + (size_t)(r - SEQ) * D;
                float* op = out + (size_t)r * D; const float* g = gate + b * MODW;
#pragma unroll
                for (int bj = 0; bj < 2; ++bj)
#pragma unroll
                    for (int n = 0; n < 2; ++n) {
                        const int c = u.pn * 256 + bj * 128 + wc * 32 + n * 16 + 4 * fq;
                        const f32x4 v = *(const f32x4*)(bp + c) + *(const f32x4*)(g + c) * acc[ai][bj][m][n];
                        *(f32x4*)(op + c) = v;
                    }
            }
    }
};


template <class F>
__device__ __forceinline__ void small_gemm(const bf16* A, const bf16* Bt, int N, int K, LAS unsigned char* lds, int bx, int G, int tid, int lane, int wave, F epi) {
    const int npieces = 16 * (N / 64), fr = lane & 15, fq = lane >> 4, kw = K / 8;
    LAS float* part = (LAS float*)lds;
    for (int p = bx; p < npieces; p += G) {
        const int xk = p >> 3, rg = xk & 15, cgi = (p & 7) * (N / 512) + (xk >> 4);
        const bf16* ap = A + (size_t)(rg * 16 + fr) * K + wave * kw + 8 * fq;
        const bf16* bp = Bt + (size_t)(cgi * 64 + fr) * K + wave * kw + 8 * fq;
        f32x4 acc[4];
#pragma unroll
        for (int i = 0; i < 4; ++i) acc[i] = (f32x4){0.f, 0.f, 0.f, 0.f};
#pragma unroll 4
        for (int ks = 0; ks < kw / 32; ++ks) {
            const bf16x8 af = *(const bf16x8*)(ap + ks * 32);
#pragma unroll
            for (int nt = 0; nt < 4; ++nt) { const bf16x8 bfr = *(const bf16x8*)(bp + (size_t)nt * 16 * K + ks * 32);
                acc[nt] = __builtin_amdgcn_mfma_f32_16x16x32_bf16(bfr, af, acc[nt], 0, 0, 0); }
        }
#pragma unroll
        for (int nt = 0; nt < 4; ++nt) *(LAS f32x4*)(part + wave * 1024 + fr * 64 + nt * 16 + 4 * fq) = acc[nt];
        __syncthreads();
        { const int r = tid >> 5, c2 = (tid & 31) * 2; float s0 = 0.f, s1 = 0.f;
#pragma unroll
          for (int w = 0; w < 8; ++w) { const f32x2 v = *(const LAS f32x2*)(part + w * 1024 + r * 64 + c2); s0 += v.x; s1 += v.y; }
          epi(rg * 16 + r, cgi * 64 + c2, s0, s1); }
        __syncthreads();
    }
}

__device__ __forceinline__ void p0_transpose_item(const float* W, int K, int N, bf16* WT, LAS float* scr, int item, int lane) {
    const int nblk = N / 32, kb = item / nblk, nb = item % nblk, k0 = 64 * kb, n0 = 32 * nb;
    float tv[32];
#pragma unroll
    for (int i = 0; i < 32; ++i) tv[i] = __builtin_nontemporal_load(W + (size_t)(k0 + 2 * i + (lane >> 5)) * N + n0 + (lane & 31));
#pragma unroll
    for (int i = 0; i < 32; ++i) scr[(2 * i + (lane >> 5)) * 33 + (lane & 31)] = tv[i];
    LDS_WAIT();
    const int c = lane & 7;
#pragma unroll
    for (int j = 0; j < 4; ++j) { const int n = (lane >> 3) + 8 * j; const LAS float* s = scr + (8 * c) * 33 + n;
        u32x4 o; o.x = pk2(s[0 * 33], s[1 * 33]); o.y = pk2(s[2 * 33], s[3 * 33]); o.z = pk2(s[4 * 33], s[5 * 33]); o.w = pk2(s[6 * 33], s[7 * 33]);
        *(u32x4*)(WT + (size_t)(n0 + n) * K + k0 + 8 * c) = o; }
    LDS_WAIT();
}
__device__ __forceinline__ void p0_transpose_mats(const float* W, int K, int N, bf16* WT, int nmat, LAS float* scr, int gw, int NGW, int lane) {
    const int per = (K / 64) * (N / 32), tot = per * nmat;
    for (int it = gw; it < tot; it += NGW) { const int mi = it / per, r = it % per;
        p0_transpose_item(W + (size_t)mi * K * N, K, N, WT + (size_t)mi * K * N, scr, r, lane); }
}
__device__ __forceinline__ void p0_mod_task(const Params& P, int task, LAS unsigned char* lds, int tid) {
    LAS float* CS = (LAS float*)lds;
    LAS float* RED = (LAS float*)(lds + NBT * D * 4);
    const int l = task / 48, e0 = (task % 48) * 128;
    { float cv[34];
#pragma unroll
      for (int j = 0; j < 34; ++j) { const int i = tid + j * NTHR; cv[j] = *(i < D ? P.in[I_CP] + i : P.in[I_CS] + (i - D)); }
#pragma unroll
      for (int j = 0; j < 34; ++j) CS[tid + j * NTHR] = silu_f(cv[j]); }
    __syncthreads();
    const int eq = tid & 31, dc = tid >> 5;
    f32x4 acc[NBT];
#pragma unroll
    for (int b = 0; b < NBT; ++b) acc[b] = (f32x4){0.f, 0.f, 0.f, 0.f};
    const float* wp = P.in[I_WADA] + ((size_t)l * D + dc * 64) * MODW + e0 + 4 * eq;
#pragma unroll 4
    for (int dd = 0; dd < 64; ++dd) {
        const f32x4 w = __builtin_nontemporal_load((const f32x4*)(wp + (size_t)dd * MODW));
#pragma unroll
        for (int b = 0; b < NBT; ++b) acc[b] += w * CS[b * D + dc * 64 + dd];
    }
    float* mod = (float*)(P.ws + WS_MOD);
#pragma unroll
    for (int b = 0; b < NBT; ++b) {
        *(LAS f32x4*)(RED + dc * 128 + 4 * eq) = acc[b];
        __syncthreads();
        if (tid < 128) { float s = P.in[I_BADA][l * MODW + e0 + tid];
#pragma unroll
            for (int k = 0; k < 16; ++k) s += RED[k * 128 + tid];
            mod[((size_t)l * NBT + b) * MODW + e0 + tid] = s; }
        __syncthreads();
    }
}
__device__ __forceinline__ void phase0(const Params& P, LAS unsigned char* lds, int tid, int lane, int wave) {
    const int G = gridDim.x, bx = blockIdx.x;
    for (int task = bx; task < 192; task += G) p0_mod_task(P, task, lds, tid);
    __syncthreads();
    LAS float* scr = (LAS float*)(lds + wave * 16384);
    const int gw = bx * NWAVES + wave, NGW = G * NWAVES;
    unsigned char* ws = P.ws;
    p0_transpose_mats(P.in[I_WUP], D, DUP, (bf16*)(ws + WS_WUP), 4, scr, gw, NGW, lane);
    p0_transpose_mats(P.in[I_WDN], DFF, D, (bf16*)(ws + WS_WDN), 4, scr, gw, NGW, lane);
    p0_transpose_mats(P.in[I_WINE], D, DINE, (bf16*)(ws + WS_WINE), 2, scr, gw, NGW, lane);
    p0_transpose_mats(P.in[I_WINO], D, DINO, (bf16*)(ws + WS_WINO), 2, scr, gw, NGW, lane);
    p0_transpose_mats(P.in[I_WOUTE], D, D, (bf16*)(ws + WS_WOUTE), 2, scr, gw, NGW, lane);
    p0_transpose_mats(P.in[I_WOUTO], D, D, (bf16*)(ws + WS_WOUTO), 2, scr, gw, NGW, lane);
    p0_transpose_mats(P.in[I_POOLW], 128, 128, (bf16*)(ws + WS_POOLW), 8, scr, gw, NGW, lane);
    f32x2* rope = (f32x2*)(ws + WS_ROPE);
    for (int i = bx * NTHR + tid; i < (SEQ + 16) * 32; i += G * NTHR) {
        const int pi = i >> 5, j = i & 31; const int pos = pi < SEQ ? pi : 4096 + (pi - SEQ);
        const float inv = exp2f(-(float)j * (13.287712379549449f / 32.0f));
        const float ang = (float)pos * inv;
        const double rev = (double)ang * 0.15915494309189535; const float fr = (float)(rev - floor(rev));
        rope[i] = (f32x2){__builtin_amdgcn_cosf(fr), __builtin_amdgcn_sinf(fr)};
    }
}

__device__ __forceinline__ void norm_phase(const float* xp, const float* xs, const float* nw, const float* mod, int sh_off, int sc_off, bf16* HM, int gw, int NGW, int lane) {
    f32x4 v0[4], v1[4], v2[4];
    auto rowp = [&](int m) { return m < SEQ ? xp + (size_t)m * D : xs + (size_t)(m - SEQ) * D; };
    if (gw < M) {
#pragma unroll
        for (int j = 0; j < 4; ++j) v0[j] = ((const f32x4*)rowp(gw))[lane + 64 * j]; }
    if (gw + NGW < M) {
#pragma unroll
        for (int j = 0; j < 4; ++j) v1[j] = ((const f32x4*)rowp(gw + NGW))[lane + 64 * j]; }
    for (int m = gw; m < M; m += NGW) {
        const int m2 = m + 2 * NGW;
        { const float* xr = rowp(m2 < M ? m2 : m);
#pragma unroll
          for (int j = 0; j < 4; ++j) v2[j] = ((const f32x4*)xr)[lane + 64 * j]; }
        const int b = m < SEQ ? 0 : 1 + ((m - SEQ) >> 4);
        const float* md = mod + b * MODW;
        f32x4 g[4], sc[4], sh[4];
#pragma unroll
        for (int j = 0; j < 4; ++j) { const int idx = 4 * (lane + 64 * j); g[j] = *(const f32x4*)(nw + idx); sc[j] = *(const f32x4*)(md + sc_off + idx); sh[j] = *(const f32x4*)(md + sh_off + idx); }
        float ss = 0.f;
#pragma unroll
        for (int j = 0; j < 4; ++j) ss += (v0[j].x * v0[j].x + v0[j].y * v0[j].y) + (v0[j].z * v0[j].z + v0[j].w * v0[j].w);
        const float rstd = 1.0f / sqrtf(wave_sum(ss) * (1.0f / D) + 1e-6f);
#pragma unroll
        for (int j = 0; j < 4; ++j) { const int idx = 4 * (lane + 64 * j);
            const f32x4 y = v0[j] * rstd * g[j] * (sc[j] + 1.0f) + sh[j];
            u32x2 w; w.x = pk2(y.x, y.y); w.y = pk2(y.z, y.w);
            *(u32x2*)(HM + (size_t)m * D + idx) = w; }
#pragma unroll
        for (int j = 0; j < 4; ++j) { v0[j] = v1[j]; v1[j] = v2[j]; }
    }
}
__device__ __forceinline__ void final_norm_phase(float* x, const float* nw, int gw, int NGW, int lane) {
    for (int m = gw; m < M; m += NGW) {
        f32x4* xr = (f32x4*)(x + (size_t)m * D);
        f32x4 v[4]; float s = 0.f;
#pragma unroll
        for (int j = 0; j < 4; ++j) { v[j] = xr[lane + 64 * j]; s += (v[j].x * v[j].x + v[j].y * v[j].y) + (v[j].z * v[j].z + v[j].w * v[j].w); }
        const float rstd = 1.0f / sqrtf(wave_sum(s) * (1.0f / D) + 1e-6f);
#pragma unroll
        for (int j = 0; j < 4; ++j) { const f32x4 g = *(const f32x4*)(nw + 4 * (lane + 64 * j)); xr[lane + 64 * j] = v[j] * rstd * g; }
    }
}

constexpr int LP = 72;
__device__ __forceinline__ void kv_unit(const bf16* PROJ, const f32x2* rope, float* KVS, int n, int hp, LAS unsigned char* lds, int tid, int lane, int wave) {
    LAS bf16* base = (LAS bf16*)lds;
#pragma unroll
    for (int it = 0; it < 2; ++it) {
        const int item = tid + it * NTHR; const int jq = item & 7, hh = (item >> 3) & 1, c = item >> 4;
        const int h = hp * 2 + hh; const int row = n * 64 + c;
        const bf16* src = PROJ + (size_t)row * DINE + 512 + h * 64 + 4 * jq;
        const u32x2 a = *(const u32x2*)src, b2 = *(const u32x2*)(src + 32);
        const float x1[4] = {bflo(a.x), bfhi(a.x), bflo(a.y), bfhi(a.y)}, x2[4] = {bflo(b2.x), bfhi(b2.x), bflo(b2.y), bfhi(b2.y)};
        const float zs = fexp2(log2_gamma(h) * (float)(63 - c)) * 0.125f;
        LAS bf16* Kt = base + hh * (2 * 64 * LP);
#pragma unroll
        for (int r = 0; r < 4; ++r) { const f32x2 cs = rope[(size_t)row * 32 + 4 * jq + r];
            Kt[(4 * jq + r) * LP + c] = f2bf((x1[r] * cs.x - x2[r] * cs.y) * zs);
            Kt[(32 + 4 * jq + r) * LP + c] = f2bf((x1[r] * cs.y + x2[r] * cs.x) * zs); }
    }
#pragma unroll
    for (int it = 0; it < 2; ++it) {
        const int item = tid + it * NTHR; const int eo = item & 7, hh = (item >> 3) & 1, s = item >> 4;
        const int h = hp * 2 + hh; const int row = n * 64 + s;
        const u32x4 v = *(const u32x4*)(PROJ + (size_t)row * DINE + 1024 + h * 64 + 8 * eo);
        LAS bf16* Vt = base + hh * (2 * 64 * LP) + 64 * LP;
        const unsigned w[4] = {v.x, v.y, v.z, v.w};
#pragma unroll
        for (int k = 0; k < 4; ++k) { Vt[(8 * eo + 2 * k) * LP + s] = (bf16)(w[k] & 0xffffu); Vt[(8 * eo + 2 * k + 1) * LP + s] = (bf16)(w[k] >> 16); }
    }
    __syncthreads();
    {
        const int hh = wave >> 2, strip = wave & 3, h = hp * 2 + hh, fr = lane & 15, fq = lane >> 4;
        const LAS bf16* Kt = base + hh * (2 * 64 * LP); const LAS bf16* Vt = Kt + 64 * LP;
        f32x4 acc[4];
#pragma unroll
        for (int i = 0; i < 4; ++i) acc[i] = (f32x4){0.f, 0.f, 0.f, 0.f};
        wave_mm<4, 2>(acc, Kt + strip * 16 * LP, LP, Vt, LP, lane);
        float* dst = KVS + (((size_t)n * 8 + h) * 64 + strip * 16 + fr) * 64 + 4 * fq;
#pragma unroll
        for (int nt = 0; nt < 4; ++nt) *(f32x4*)(dst + nt * 16) = acc[nt];
    }
    __syncthreads();
}
__device__ __forceinline__ void sconv_items(const Params& P, int li, const bf16* PROJ, bf16* MIX, int gtid, int GT) {
    const float* cw = P.in[I_SCW] + (size_t)li * 3 * 512;
    const float* sbuf = P.in[I_SSCONV] + (size_t)li * 16 * 2 * 512;
    for (int item = gtid; item < M * 64; item += GT) {
        const int co = item & 63, m = item >> 6, c = 8 * co;
        const int t = m < SEQ ? m : (m - SEQ) & 15; const int b = m < SEQ ? 0 : (m - SEQ) >> 4;
        float u[3][8];
        u32x4 gcv[3], hvv[3];
#pragma unroll
        for (int k = 0; k < 3; ++k) {
            const bf16* rp = PROJ + (size_t)(t - 2 + k >= 0 ? m - 2 + k : m) * DINE;
            gcv[k] = *(const u32x4*)(rp + 2560 + c); hvv[k] = *(const u32x4*)(rp + 3072 + c);
        }
#pragma unroll
        for (int k = 0; k < 3; ++k) {
            const unsigned g4[4] = {gcv[k].x, gcv[k].y, gcv[k].z, gcv[k].w}, h4[4] = {hvv[k].x, hvv[k].y, hvv[k].z, hvv[k].w};
            const bool valid = t - 2 + k >= 0;
#pragma unroll
            for (int q = 0; q < 4; ++q) { u[k][2 * q] = valid ? bflo(g4[q]) * bflo(h4[q]) : 0.f; u[k][2 * q + 1] = valid ? bfhi(g4[q]) * bfhi(h4[q]) : 0.f; }
        }
        if (m >= SEQ && t < 2) {
#pragma unroll
            for (int k = 0; k < 2; ++k) if (t - 2 + k < 0) { const float* sp = sbuf + ((size_t)b * 2 + (t + k)) * 512 + c;
#pragma unroll
                for (int q = 0; q < 8; ++q) u[k][q] = sp[q]; }
        }
        const u32x4 gb = *(const u32x4*)(PROJ + (size_t)m * DINE + 2048 + c);
        const unsigned gb4[4] = {gb.x, gb.y, gb.z, gb.w};
        float y[8];
#pragma unroll
        for (int q = 0; q < 8; ++q) {
            const float conv = cw[c + q] * u[0][q] + cw[512 + c + q] * u[1][q] + cw[1024 + c + q] * u[2][q];
            const float g = (q & 1) ? bfhi(gb4[q >> 1]) : bflo(gb4[q >> 1]);
            y[q] = g * conv;
        }
        u32x4 o; o.x = pk2(y[0], y[1]); o.y = pk2(y[2], y[3]); o.z = pk2(y[4], y[5]); o.w = pk2(y[6], y[7]);
        *(u32x4*)(MIX + (size_t)m * D + 512 + c) = o;
        float* dst = nullptr;
        if (m < SEQ) { if (m >= SEQ - 2) dst = P.out + O_SCP + ((size_t)li * 2 + (m - (SEQ - 2))) * 512 + c; }
        else if (t >= 14) dst = P.out + O_SCS + (((size_t)li * 16 + b) * 2 + (t - 14)) * 512 + c;
        if (dst) {
#pragma unroll
            for (int q = 0; q < 8; ++q) dst[q] = u[2][q];
        }
    }
}
__device__ __forceinline__ void scan_task(float* KVS, float* retp, int w, LAS unsigned char* lds, int tid) {
    LAS float* TOT = (LAS float*)lds;
    const int e = tid & 127, seg = tid >> 7, el = w * 128 + e, h = el >> 12;
    const float l2g = log2_gamma(h), g64 = fexp2(l2g * 64.0f), g4096 = fexp2(l2g * 4096.0f);
    float* p = KVS + (size_t)(seg * 64) * 32768 + el;
    float v[64];
#pragma unroll
    for (int k = 0; k < 64; ++k) v[k] = p[(size_t)k * 32768];
    float tot = 0.f;
#pragma unroll
    for (int k = 0; k < 64; ++k) tot = tot * g64 + v[k];
    TOT[seg * 128 + e] = tot;
    __syncthreads();
    float R = 0.f;
    for (int s = 0; s < seg; ++s) R = R * g4096 + TOT[s * 128 + e];
#pragma unroll
    for (int k = 0; k < 64; ++k) { p[(size_t)k * 32768] = R; R = R * g64 + v[k]; }
    if (seg == 3) retp[el] = R;
    __syncthreads();
}
__device__ __forceinline__ void retout_unit(const Params& P, int li, const bf16* PROJ, const f32x2* rope, const float* KVS, bf16* MIX, int n, int hp,
                                            LAS unsigned char* lds, int tid, int lane, int wave) {
    constexpr int HB = 5 * 64 * LP;
    LAS bf16* base = (LAS bf16*)lds;
#pragma unroll
    for (int it = 0; it < 4; ++it) {
        const int item = tid + it * NTHR; const int jq = item & 7, qk = (item >> 3) & 1, hh = (item >> 4) & 1, c = item >> 5;
        const int h = hp * 2 + hh; const int row = n * 64 + c;
        const bf16* src = PROJ + (size_t)row * DINE + qk * 512 + h * 64 + 4 * jq;
        const u32x2 a = *(const u32x2*)src, b2 = *(const u32x2*)(src + 32);
        const float x1[4] = {bflo(a.x), bfhi(a.x), bflo(a.y), bfhi(a.y)}, x2[4] = {bflo(b2.x), bfhi(b2.x), bflo(b2.y), bfhi(b2.y)};
        const float sc = qk ? 0.125f : 1.0f;
        float o1[4], o2[4];
#pragma unroll
        for (int r = 0; r < 4; ++r) { const f32x2 cs = rope[(size_t)row * 32 + 4 * jq + r];
            o1[r] = (x1[r] * cs.x - x2[r] * cs.y) * sc; o2[r] = (x1[r] * cs.y + x2[r] * cs.x) * sc; }
        LAS bf16* dst = base + hh * HB + qk * (64 * LP) + c * LP + 4 * jq;
        u32x2 w1, w2; w1.x = pk2(o1[0], o1[1]); w1.y = pk2(o1[2], o1[3]); w2.x = pk2(o2[0], o2[1]); w2.y = pk2(o2[2], o2[3]);
        *(LAS u32x2*)dst = w1; *(LAS u32x2*)(dst + 32) = w2;
    }
#pragma unroll
    for (int it = 0; it < 2; ++it) {
        const int item = tid + it * NTHR; const int eo = item & 7, hh = (item >> 3) & 1, s = item >> 4;
        const int h = hp * 2 + hh; const int row = n * 64 + s;
        const u32x4 v = *(const u32x4*)(PROJ + (size_t)row * DINE + 1024 + h * 64 + 8 * eo);
        LAS bf16* Vt = base + hh * HB + 2 * 64 * LP;
        const unsigned w[4] = {v.x, v.y, v.z, v.w};
#pragma unroll
        for (int k = 0; k < 4; ++k) { Vt[(8 * eo + 2 * k) * LP + s] = (bf16)(w[k] & 0xffffu); Vt[(8 * eo + 2 * k + 1) * LP + s] = (bf16)(w[k] >> 16); }
    }
#pragma unroll
    for (int it = 0; it < 4; ++it) {
        const int item = tid + it * NTHR; const int eq = item & 15, hh = (item >> 4) & 1, d = item >> 5;
        const int h = hp * 2 + hh;
        const f32x4 v = *(const f32x4*)(KVS + (((size_t)n * 8 + h) * 64 + d) * 64 + 4 * eq);
        LAS bf16* Rt = base + hh * HB + 3 * 64 * LP;
#pragma unroll
        for (int k = 0; k < 4; ++k) Rt[(4 * eq + k) * LP + d] = f2bf(v[k]);
    }
    __syncthreads();
    {
        const int hh = wave >> 2, strip = wave & 3, h = hp * 2 + hh, fr = lane & 15, fq = lane >> 4;
        const LAS bf16* Qs = base + hh * HB + strip * 16 * LP; const LAS bf16* Ks = base + hh * HB + 64 * LP;
        const LAS bf16* Vt = base + hh * HB + 2 * 64 * LP; const LAS bf16* Rt = base + hh * HB + 3 * 64 * LP;
        LAS bf16* Pw = base + hh * HB + 4 * 64 * LP + strip * 16 * LP;
        const float l2g = log2_gamma(h);
        const int t = strip * 16 + fr;
        f32x4 S[4], O1[4], O2[4];
#pragma unroll
        for (int i = 0; i < 4; ++i) { S[i] = (f32x4){0.f, 0.f, 0.f, 0.f}; O1[i] = S[i]; O2[i] = S[i]; }
        wave_mm<4, 2>(S, Qs, LP, Ks, LP, lane);
#pragma unroll
        for (int nt = 0; nt < 4; ++nt) {
            float pv[4];
#pragma unroll
            for (int r = 0; r < 4; ++r) { const int dl = t - (nt * 16 + 4 * fq + r); pv[r] = dl >= 0 ? S[nt][r] * fexp2(l2g * (float)dl) : 0.f; }
            u32x2 w; w.x = pk2(pv[0], pv[1]); w.y = pk2(pv[2], pv[3]);
            *(LAS u32x2*)(Pw + fr * LP + nt * 16 + 4 * fq) = w;
        }
        LDS_WAIT();
        wave_mm<4, 2>(O1, Pw, LP, Vt, LP, lane);
        wave_mm<4, 2>(O2, Qs, LP, Rt, LP, lane);
        const float xi = fexp2(l2g * (float)(t + 1));
        float s = 0.f;
#pragma unroll
        for (int nt = 0; nt < 4; ++nt) { O1[nt] = O1[nt] + O2[nt] * xi; s += (O1[nt][0] + O1[nt][1]) + (O1[nt][2] + O1[nt][3]); }
        s = xrow16_sum(s);
        const float mean = s * (1.0f / 64.0f); float q = 0.f;
#pragma unroll
        for (int nt = 0; nt < 4; ++nt) { O1[nt] = O1[nt] - mean; q += (O1[nt][0] * O1[nt][0] + O1[nt][1] * O1[nt][1]) + (O1[nt][2] * O1[nt][2] + O1[nt][3] * O1[nt][3]); }
        q = xrow16_sum(q);
        const float rstd = 1.0f / sqrtf(q * (1.0f / 64.0f) + 1e-6f);
        const int row = n * 64 + t;
        const float* gain = P.in[I_GN] + (size_t)li * 512 + h * 64;
#pragma unroll
        for (int nt = 0; nt < 4; ++nt) { const int e = nt * 16 + 4 * fq;
            const u32x2 gg = *(const u32x2*)(PROJ + (size_t)row * DINE + 1536 + h * 64 + e);
            const f32x4 gn = *(const f32x4*)(gain + e);
            const float g0 = silu_f(bflo(gg.x)), g1 = silu_f(bfhi(gg.x)), g2 = silu_f(bflo(gg.y)), g3 = silu_f(bfhi(gg.y));
            u32x2 w; w.x = pk2(g0 * O1[nt][0] * rstd * gn[0], g1 * O1[nt][1] * rstd * gn[1]); w.y = pk2(g2 * O1[nt][2] * rstd * gn[2], g3 * O1[nt][3] * rstd * gn[3]);
            *(u32x2*)(MIX + (size_t)row * D + h * 64 + e) = w; }
    }
    __syncthreads();
}

__device__ __forceinline__ void kv_units_pipelined(const bf16* PROJ, const f32x2* rope, float* KVS, int bx, int G, LAS unsigned char* lds, int tid, int lane, int wave) {
    LAS bf16* base = (LAS bf16*)lds;
    u32x2 ka[2], kb[2]; f32x2 cs[2][4]; u32x4 vv[2];
    auto gload = [&](int u) { const int n = u >> 2, hp = u & 3;
#pragma unroll
        for (int it = 0; it < 2; ++it) { const int item = tid + it * NTHR;
            { const int jq = item & 7, hh = (item >> 3) & 1, c = item >> 4; const int row = n * 64 + c;
              const bf16* src = PROJ + (size_t)row * DINE + 512 + (hp * 2 + hh) * 64 + 4 * jq;
              ka[it] = *(const u32x2*)src; kb[it] = *(const u32x2*)(src + 32);
#pragma unroll
              for (int r = 0; r < 4; ++r) cs[it][r] = rope[(size_t)row * 32 + 4 * jq + r]; }
            { const int eo = item & 7, hh = (item >> 3) & 1, s = item >> 4;
              vv[it] = *(const u32x4*)(PROJ + (size_t)(n * 64 + s) * DINE + 1024 + (hp * 2 + hh) * 64 + 8 * eo); } } };
    auto lstore = [&](int u) { const int hp = u & 3;
#pragma unroll
        for (int it = 0; it < 2; ++it) { const int item = tid + it * NTHR;
            { const int jq = item & 7, hh = (item >> 3) & 1, c = item >> 4; const int h = hp * 2 + hh;
              const u32x2 a = ka[it], b2 = kb[it];
              const float x1[4] = {bflo(a.x), bfhi(a.x), bflo(a.y), bfhi(a.y)}, x2[4] = {bflo(b2.x), bfhi(b2.x), bflo(b2.y), bfhi(b2.y)};
              const float zs = fexp2(log2_gamma(h) * (float)(63 - c)) * 0.125f;
              LAS bf16* Kt = base + hh * (2 * 64 * LP);
#pragma unroll
              for (int r = 0; r < 4; ++r) { const f32x2 c2 = cs[it][r];
                  Kt[(4 * jq + r) * LP + c] = f2bf((x1[r] * c2.x - x2[r] * c2.y) * zs);
                  Kt[(32 + 4 * jq + r) * LP + c] = f2bf((x1[r] * c2.y + x2[r] * c2.x) * zs); } }
            { const int eo = item & 7, hh = (item >> 3) & 1, s = item >> 4;
              LAS bf16* Vt = base + hh * (2 * 64 * LP) + 64 * LP;
              const unsigned w[4] = {vv[it].x, vv[it].y, vv[it].z, vv[it].w};
#pragma unroll
              for (int k = 0; k < 4; ++k) { Vt[(8 * eo + 2 * k) * LP + s] = (bf16)(w[k] & 0xffffu); Vt[(8 * eo + 2 * k + 1) * LP + s] = (bf16)(w[k] >> 16); } } } };
    int u = bx; if (u >= 1024) return;
    gload(u);
    for (; u < 1024; u += G) {
        lstore(u);
        __syncthreads();
        if (u + G < 1024) gload(u + G);
        {
            const int n = u >> 2, hp = u & 3, hh = wave >> 2, strip = wave & 3, h = hp * 2 + hh, fr = lane & 15, fq = lane >> 4;
            const LAS bf16* Kt = base + hh * (2 * 64 * LP); const LAS bf16* Vt = Kt + 64 * LP;
            f32x4 acc[4];
#pragma unroll
            for (int i = 0; i < 4; ++i) acc[i] = (f32x4){0.f, 0.f, 0.f, 0.f};
            wave_mm<4, 2>(acc, Kt + strip * 16 * LP, LP, Vt, LP, lane);
            float* dst = KVS + (((size_t)n * 8 + h) * 64 + strip * 16 + fr) * 64 + 4 * fq;
#pragma unroll
            for (int nt = 0; nt < 4; ++nt) *(f32x4*)(dst + nt * 16) = acc[nt];
        }
        __syncthreads();
    }
}
__device__ __forceinline__ void retout_units_pipelined(const Params& P, int li, const bf16* PROJ, const f32x2* rope, const float* KVS, bf16* MIX, int bx, int G,
                                                       LAS unsigned char* lds, int tid, int lane, int wave) {
    constexpr int HB = 5 * 64 * LP;
    LAS bf16* base = (LAS bf16*)lds;
    u32x2 qa[4], qb[4]; f32x2 cs[4][4]; u32x4 vv[2]; f32x4 rr[4];
    auto gload = [&](int u) { const int n = u >> 2, hp = u & 3;
#pragma unroll
        for (int it = 0; it < 4; ++it) { const int item = tid + it * NTHR; const int jq = item & 7, qk = (item >> 3) & 1, hh = (item >> 4) & 1, c = item >> 5; const int row = n * 64 + c;
            const bf16* src = PROJ + (size_t)row * DINE + qk * 512 + (hp * 2 + hh) * 64 + 4 * jq;
            qa[it] = *(const u32x2*)src; qb[it] = *(const u32x2*)(src + 32);
#pragma unroll
            for (int r = 0; r < 4; ++r) cs[it][r] = rope[(size_t)row * 32 + 4 * jq + r];
            { const int eq = item & 15, h2 = (item >> 4) & 1, d = item >> 5;
              rr[it] = *(const f32x4*)(KVS + (((size_t)n * 8 + hp * 2 + h2) * 64 + d) * 64 + 4 * eq); } }
#pragma unroll
        for (int it = 0; it < 2; ++it) { const int item = tid + it * NTHR; const int eo = item & 7, hh = (item >> 3) & 1, s = item >> 4;
            vv[it] = *(const u32x4*)(PROJ + (size_t)(n * 64 + s) * DINE + 1024 + (hp * 2 + hh) * 64 + 8 * eo); } };
    auto lstore = [&]() {
#pragma unroll
        for (int it = 0; it < 4; ++it) { const int item = tid + it * NTHR; const int jq = item & 7, qk = (item >> 3) & 1, hh = (item >> 4) & 1, c = item >> 5;
            const u32x2 a = qa[it], b2 = qb[it];
            const float x1[4] = {bflo(a.x), bfhi(a.x), bflo(a.y), bfhi(a.y)}, x2[4] = {bflo(b2.x), bfhi(b2.x), bflo(b2.y), bfhi(b2.y)};
            const float sc = qk ? 0.125f : 1.0f;
            float o1[4], o2[4];
#pragma unroll
            for (int r = 0; r < 4; ++r) { const f32x2 c2 = cs[it][r]; o1[r] = (x1[r] * c2.x - x2[r] * c2.y) * sc; o2[r] = (x1[r] * c2.y + x2[r] * c2.x) * sc; }
            LAS bf16* dst = base + hh * HB + qk * (64 * LP) + c * LP + 4 * jq;
            u32x2 w1, w2; w1.x = pk2(o1[0], o1[1]); w1.y = pk2(o1[2], o1[3]); w2.x = pk2(o2[0], o2[1]); w2.y = pk2(o2[2], o2[3]);
            *(LAS u32x2*)dst = w1; *(LAS u32x2*)(dst + 32) = w2;
            { const int eq = item & 15, h2 = (item >> 4) & 1, d = item >> 5; LAS bf16* Rt = base + h2 * HB + 3 * 64 * LP;
#pragma unroll
              for (int k = 0; k < 4; ++k) Rt[(4 * eq + k) * LP + d] = f2bf(rr[it][k]); } }
#pragma unroll
        for (int it = 0; it < 2; ++it) { const int item = tid + it * NTHR; const int eo = item & 7, hh = (item >> 3) & 1, s = item >> 4;
            LAS bf16* Vt = base + hh * HB + 2 * 64 * LP; const unsigned w[4] = {vv[it].x, vv[it].y, vv[it].z, vv[it].w};
#pragma unroll
            for (int k = 0; k < 4; ++k) { Vt[(8 * eo + 2 * k) * LP + s] = (bf16)(w[k] & 0xffffu); Vt[(8 * eo + 2 * k + 1) * LP + s] = (bf16)(w[k] >> 16); } } };
    int u = bx; if (u >= 1024) return;
    gload(u);
    for (; u < 1024; u += G) {
        lstore();
        __syncthreads();
        if (u + G < 1024) gload(u + G);
        {
            const int n = u >> 2, hp = u & 3, hh = wave >> 2, strip = wave & 3, h = hp * 2 + hh, fr = lane & 15, fq = lane >> 4;
            const LAS bf16* Qs = base + hh * HB + strip * 16 * LP; const LAS bf16* Ks = base + hh * HB + 64 * LP;
            const LAS bf16* Vt = base + hh * HB + 2 * 64 * LP; const LAS bf16* Rt = base + hh * HB + 3 * 64 * LP;
            LAS bf16* Pw = base + hh * HB + 4 * 64 * LP + strip * 16 * LP;
            const float l2g = log2_gamma(h);
            const int t = strip * 16 + fr;
            f32x4 S[4], O1[4], O2[4];
#pragma unroll
            for (int i = 0; i < 4; ++i) { S[i] = (f32x4){0.f, 0.f, 0.f, 0.f}; O1[i] = S[i]; O2[i] = S[i]; }
            wave_mm<4, 2>(S, Qs, LP, Ks, LP, lane);
#pragma unroll
            for (int nt = 0; nt < 4; ++nt) {
                float pv[4];
#pragma unroll
                for (int r = 0; r < 4; ++r) { const int dl = t - (nt * 16 + 4 * fq + r); pv[r] = dl >= 0 ? S[nt][r] * fexp2(l2g * (float)dl) : 0.f; }
                u32x2 w; w.x = pk2(pv[0], pv[1]); w.y = pk2(pv[2], pv[3]);
                *(LAS u32x2*)(Pw + fr * LP + nt * 16 + 4 * fq) = w;
            }
            wave_mm<4, 2>(O1, Pw, LP, Vt, LP, lane);
            wave_mm<4, 2>(O2, Qs, LP, Rt, LP, lane);
            const float xi = fexp2(l2g * (float)(t + 1));
            float s = 0.f;
#pragma unroll
            for (int nt = 0; nt < 4; ++nt) { O1[nt] = O1[nt] + O2[nt] * xi; s += (O1[nt][0] + O1[nt][1]) + (O1[nt][2] + O1[nt][3]); }
            s = xrow16_sum(s);
            const float mean = s * (1.0f / 64.0f); float q = 0.f;
#pragma unroll
            for (int nt = 0; nt < 4; ++nt) { O1[nt] = O1[nt] - mean; q += (O1[nt][0] * O1[nt][0] + O1[nt][1] * O1[nt][1]) + (O1[nt][2] * O1[nt][2] + O1[nt][3] * O1[nt][3]); }
            q = xrow16_sum(q);
            const float rstd = 1.0f / sqrtf(q * (1.0f / 64.0f) + 1e-6f);
            const int row = n * 64 + t;
            const float* gain = P.in[I_GN] + (size_t)li * 512 + h * 64;
#pragma unroll
            for (int nt = 0; nt < 4; ++nt) { const int e = nt * 16 + 4 * fq;
                const u32x2 gg = *(const u32x2*)(PROJ + (size_t)row * DINE + 1536 + h * 64 + e);
                const f32x4 gn = *(const f32x4*)(gain + e);
                const float g0 = silu_f(bflo(gg.x)), g1 = silu_f(bfhi(gg.x)), g2 = silu_f(bflo(gg.y)), g3 = silu_f(bfhi(gg.y));
                u32x2 w; w.x = pk2(g0 * O1[nt][0] * rstd * gn[0], g1 * O1[nt][1] * rstd * gn[1]); w.y = pk2(g2 * O1[nt][2] * rstd * gn[2], g3 * O1[nt][3] * rstd * gn[3]);
                *(u32x2*)(MIX + (size_t)row * D + h * 64 + e) = w; }
        }
        __syncthreads();
    }
}

__device__ __forceinline__ void retstep_unit(const Params& P, int li, const bf16* PROJ, const f32x2* rope, bf16* MIX, int b, int h, LAS unsigned char* lds, int tid, int lane, int wave) {
    LAS float* q = (LAS float*)lds; LAS float* k = q + 1024; LAS float* v = k + 1024; LAS float* S = v + 1024; LAS float* sc = S + 4096;
    const float l2g = log2_gamma(h);
    const int row0 = SEQ + b * 16;
    { const int t = tid >> 5, j = tid & 31; const bf16* rp = PROJ + (size_t)(row0 + t) * DINE + h * 64;
      const f32x2 cs = rope[(size_t)(SEQ + t) * 32 + j];
      const float q1 = bf2f(rp[j]), q2 = bf2f(rp[32 + j]), k1 = bf2f(rp[512 + j]), k2 = bf2f(rp[512 + 32 + j]);
      q[t * 64 + j] = q1 * cs.x - q2 * cs.y; q[t * 64 + 32 + j] = q1 * cs.y + q2 * cs.x;
      k[t * 64 + j] = (k1 * cs.x - k2 * cs.y) * 0.125f; k[t * 64 + 32 + j] = (k1 * cs.y + k2 * cs.x) * 0.125f;
      v[t * 64 + j] = bf2f(rp[1024 + j]); v[t * 64 + 32 + j] = bf2f(rp[1024 + 32 + j]); }
    const float* Sg = P.in[I_SRET] + (((size_t)li * 16 + b) * 8 + h) * 4096;
#pragma unroll
    for (int i = 0; i < 8; ++i) S[tid + i * NTHR] = Sg[tid + i * NTHR];
    __syncthreads();
    if (tid < 256) { const int t = tid >> 4, s = tid & 15; float a = 0.f;
        if (s <= t) { for (int d = 0; d < 64; ++d) a += q[t * 64 + d] * k[s * 64 + d]; a *= fexp2(l2g * (float)(t - s)); }
        sc[tid] = a; }
    __syncthreads();
    {
        const int t0 = wave, t1 = wave + 8, e = lane; float in0 = 0.f, in1 = 0.f, cr0 = 0.f, cr1 = 0.f;
#pragma unroll
        for (int s4 = 0; s4 < 4; ++s4) { const f32x4 sa = *(const LAS f32x4*)(sc + t0 * 16 + 4 * s4), sb = *(const LAS f32x4*)(sc + t1 * 16 + 4 * s4);
#pragma unroll
            for (int j = 0; j < 4; ++j) { const float vv = v[(4 * s4 + j) * 64 + e]; in0 += sa[j] * vv; in1 += sb[j] * vv; } }
#pragma unroll 4
        for (int d4 = 0; d4 < 16; ++d4) { const f32x4 qa = *(const LAS f32x4*)(q + t0 * 64 + 4 * d4), qb = *(const LAS f32x4*)(q + t1 * 64 + 4 * d4);
#pragma unroll
            for (int j = 0; j < 4; ++j) { const float sv = S[(4 * d4 + j) * 64 + e]; cr0 += qa[j] * sv; cr1 += qb[j] * sv; } }
#pragma unroll
        for (int tt = 0; tt < 2; ++tt) {
            const int t = tt ? t1 : t0;
            float o = (tt ? in1 : in0) + (tt ? cr1 : cr0) * fexp2(l2g * (float)(t + 1));
            const float mean = wave_sum(o) * (1.0f / 64.0f); o -= mean;
            const float rstd = 1.0f / sqrtf(wave_sum(o * o) * (1.0f / 64.0f) + 1e-6f);
            const float g = bf2f(PROJ[(size_t)(row0 + t) * DINE + 1536 + h * 64 + e]);
            MIX[(size_t)(row0 + t) * D + h * 64 + e] = f2bf(silu_f(g) * o * rstd * P.in[I_GN][li * 512 + h * 64 + e]);
        }
    }
    float* Sn = P.out + O_RETS + (((size_t)li * 16 + b) * 8 + h) * 4096;
    const float g16 = fexp2(l2g * 16.0f);
    {
        const int e = tid & 63, d0 = tid >> 6; float a[8];
#pragma unroll
        for (int i = 0; i < 8; ++i) a[i] = S[tid + i * NTHR] * g16;
#pragma unroll 4
        for (int t = 0; t < 16; ++t) { const float vz = v[t * 64 + e] * fexp2(l2g * (float)(15 - t));
#pragma unroll
            for (int i = 0; i < 8; ++i) a[i] += k[t * 64 + d0 + 8 * i] * vz; }
#pragma unroll
        for (int i = 0; i < 8; ++i) Sn[tid + i * NTHR] = a[i];
    }
    __syncthreads();
}

__device__ __forceinline__ void attn_block(f32x4 (&O)[4], float& mrun, float& lrun, const LAS bf16* Qw, const LAS bf16* Kb, const LAS bf16* Vtb, LAS bf16* Pw,
                                           const LAS float* bias, int iq, int jbase, int nvalid, int lane) {
    const int fr = lane & 15, fq = lane >> 4;
    f32x4 S[4];
#pragma unroll
    for (int i = 0; i < 4; ++i) S[i] = (f32x4){0.f, 0.f, 0.f, 0.f};
    wave_mm<4, 2>(S, Qw, LP, Kb, LP, lane);
    float mx = -1e30f;
#pragma unroll
    for (int nt = 0; nt < 4; ++nt)
#pragma unroll
        for (int r = 0; r < 4; ++r) { const int j = nt * 16 + 4 * fq + r; int rel = 512 + iq - (jbase + j); rel = rel < -63 ? -63 : (rel > 256 ? 256 : rel);
            float s = S[nt][r] * 0.125f + bias[rel + 63]; if (j >= nvalid) s = -1e30f; S[nt][r] = s; mx = fmaxf(mx, s); }
    mx = fmaxf(mx, __shfl_xor(mx, 16)); mx = fmaxf(mx, __shfl_xor(mx, 32));
    const float mnew = fmaxf(mrun, mx), alpha = __expf(mrun - mnew);
    float ps = 0.f;
#pragma unroll
    for (int nt = 0; nt < 4; ++nt) {
        float p[4];
#pragma unroll
        for (int r = 0; r < 4; ++r) { p[r] = __expf(S[nt][r] - mnew); ps += p[r]; }
        u32x2 w; w.x = pk2(p[0], p[1]); w.y = pk2(p[2], p[3]);
        *(LAS u32x2*)(Pw + fr * LP + nt * 16 + 4 * fq) = w;
        O[nt] = O[nt] * alpha;
    }
    ps += __shfl_xor(ps, 16); ps += __shfl_xor(ps, 32);
    lrun = lrun * alpha + ps; mrun = mnew;
    LDS_WAIT();
    wave_mm<4, 2>(O, Pw, LP, Vtb, LP, lane);
}
__device__ __forceinline__ void attn_prompt_unit(const Params& P, int li, const bf16* PROJ, bf16* MIX, int n, int hp, LAS unsigned char* lds, int tid, int lane, int wave) {
    constexpr int HB = 4 * 64 * LP;
    LAS bf16* base = (LAS bf16*)lds; LAS float* biasb = (LAS float*)(lds + 2 * HB * 2);
#pragma unroll
    for (int it = 0; it < 2; ++it) {
        const int item = tid + it * NTHR; const int eo = item & 7, hh = (item >> 3) & 1, c = item >> 4; const int h = hp * 2 + hh;
        *(LAS u32x4*)(base + hh * HB + c * LP + 8 * eo) = *(const u32x4*)(PROJ + (size_t)(n * 64 + c) * DINO + 512 + h * 64 + 8 * eo);
    }
    for (int i = tid; i < 640; i += NTHR) { const int hh = i / 320, k = i % 320; biasb[i] = P.in[I_REL][((size_t)li * 8 + hp * 2 + hh) * 320 + k]; }
    const int hh = wave >> 2, strip = wave & 3, h = hp * 2 + hh, fr = lane & 15, fq = lane >> 4;
    f32x4 O[4];
#pragma unroll
    for (int i = 0; i < 4; ++i) O[i] = (f32x4){0.f, 0.f, 0.f, 0.f};
    float mrun = -1e30f, lrun = 0.f;
    for (int kb = (n < 8 ? 8 - n : 0); kb <= 8; ++kb) {
        const int kc = n - 8 + kb;
        __syncthreads();
#pragma unroll
        for (int it = 0; it < 2; ++it) {
            const int item = tid + it * NTHR; const int eo = item & 7, h2 = (item >> 3) & 1, s = item >> 4; const int hd = hp * 2 + h2;
            const bf16* rp = PROJ + (size_t)(kc * 64 + s) * DINO + hd * 64 + 8 * eo;
            *(LAS u32x4*)(base + h2 * HB + 64 * LP + s * LP + 8 * eo) = *(const u32x4*)(rp + 1024);
            const u32x4 v = *(const u32x4*)(rp + 1536);
            LAS bf16* Vt = base + h2 * HB + 2 * 64 * LP;
            const unsigned w[4] = {v.x, v.y, v.z, v.w};
#pragma unroll
            for (int k = 0; k < 4; ++k) { Vt[(8 * eo + 2 * k) * LP + s] = (bf16)(w[k] & 0xffffu); Vt[(8 * eo + 2 * k + 1) * LP + s] = (bf16)(w[k] >> 16); }
        }
        __syncthreads();
        attn_block(O, mrun, lrun, base + hh * HB + strip * 16 * LP, base + hh * HB + 64 * LP, base + hh * HB + 2 * 64 * LP, base + hh * HB + 3 * 64 * LP + strip * 16 * LP,
                   biasb + hh * 320, strip * 16 + fr, kb * 64, 64, lane);
    }
    const float inv = 1.0f / lrun; const int row = n * 64 + strip * 16 + fr;
#pragma unroll
    for (int nt = 0; nt < 4; ++nt) { u32x2 w; w.x = pk2(O[nt][0] * inv, O[nt][1] * inv); w.y = pk2(O[nt][2] * inv, O[nt][3] * inv);
        *(u32x2*)(MIX + (size_t)row * D + 512 + h * 64 + nt * 16 + 4 * fq) = w; }
    __syncthreads();
}
__device__ __forceinline__ void attn_sample_unit(const Params& P, int li, const bf16* PROJ, bf16* MIX, int b, int hq, LAS unsigned char* lds, int tid, int lane, int wave) {
    constexpr int HB = (16 + 64 + 64 + 16) * LP;
    LAS bf16* base = (LAS bf16*)lds; LAS float* biasb = (LAS float*)(lds + 4 * HB * 2);
    const int row0 = SEQ + b * 16;
    { const int eo = tid & 7, h4 = (tid >> 3) & 3, t = tid >> 5;
      *(LAS u32x4*)(base + h4 * HB + t * LP + 8 * eo) = *(const u32x4*)(PROJ + (size_t)(row0 + t) * DINO + 512 + (hq * 4 + h4) * 64 + 8 * eo); }
    for (int i = tid; i < 1280; i += NTHR) { const int h4 = i / 320, k = i % 320; biasb[i] = P.in[I_REL][((size_t)li * 8 + hq * 4 + h4) * 320 + k]; }
    const int fr = lane & 15, fq = lane >> 4;
    f32x4 O[4];
#pragma unroll
    for (int i = 0; i < 4; ++i) O[i] = (f32x4){0.f, 0.f, 0.f, 0.f};
    float mrun = -1e30f, lrun = 0.f;
    const float* ck = P.in[I_CK] + ((size_t)li * 16 + b) * 512 * 512; const float* cv = P.in[I_CV] + ((size_t)li * 16 + b) * 512 * 512;
    for (int kb = 0; kb <= 8; ++kb) {
        __syncthreads();
#pragma unroll
        for (int it = 0; it < 4; ++it) {
            const int item = tid + it * NTHR; const int eo = item & 7, h4 = (item >> 3) & 3, s = item >> 5; const int hd = hq * 4 + h4;
            float kf[8], vf[8];
            if (kb < 8) {
                const float* kp = ck + (size_t)(kb * 64 + s) * 512 + hd * 64 + 8 * eo; const float* vp = cv + (size_t)(kb * 64 + s) * 512 + hd * 64 + 8 * eo;
                const f32x4 k0 = *(const f32x4*)kp, k1 = *(const f32x4*)(kp + 4), v0 = *(const f32x4*)vp, v1 = *(const f32x4*)(vp + 4);
#pragma unroll
                for (int q = 0; q < 4; ++q) { kf[q] = k0[q]; kf[4 + q] = k1[q]; vf[q] = v0[q]; vf[4 + q] = v1[q]; }
            } else if (s < 16) {
                const bf16* rp = PROJ + (size_t)(row0 + s) * DINO + hd * 64 + 8 * eo;
                const u32x4 kk = *(const u32x4*)(rp + 1024), vv = *(const u32x4*)(rp + 1536);
                const unsigned k4[4] = {kk.x, kk.y, kk.z, kk.w}, v4[4] = {vv.x, vv.y, vv.z, vv.w};
#pragma unroll
                for (int q = 0; q < 4; ++q) { kf[2 * q] = bflo(k4[q]); kf[2 * q + 1] = bfhi(k4[q]); vf[2 * q] = bflo(v4[q]); vf[2 * q + 1] = bfhi(v4[q]); }
            } else {
#pragma unroll
                for (int q = 0; q < 8; ++q) { kf[q] = 0.f; vf[q] = 0.f; }
            }
            u32x4 kw; kw.x = pk2(kf[0], kf[1]); kw.y = pk2(kf[2], kf[3]); kw.z = pk2(kf[4], kf[5]); kw.w = pk2(kf[6], kf[7]);
            *(LAS u32x4*)(base + h4 * HB + 16 * LP + s * LP + 8 * eo) = kw;
            LAS bf16* Vt = base + h4 * HB + (16 + 64) * LP;
#pragma unroll
            for (int q = 0; q < 8; ++q) Vt[(8 * eo + q) * LP + s] = f2bf(vf[q]);
        }
        __syncthreads();
        if (wave < 4)
            attn_block(O, mrun, lrun, base + wave * HB, base + wave * HB + 16 * LP, base + wave * HB + (16 + 64) * LP, base + wave * HB + (16 + 64 + 64) * LP,
                       biasb + wave * 320, fr, kb * 64, kb < 8 ? 64 : 16, lane);
    }
    if (wave < 4) {
        const float inv = 1.0f / lrun; const int row = row0 + fr, h = hq * 4 + wave;
#pragma unroll
        for (int nt = 0; nt < 4; ++nt) { u32x2 w; w.x = pk2(O[nt][0] * inv, O[nt][1] * inv); w.y = pk2(O[nt][2] * inv, O[nt][3] * inv);
            *(u32x2*)(MIX + (size_t)row * D + 512 + h * 64 + nt * 16 + 4 * fq) = w; }
    }
    __syncthreads();
}

__device__ __forceinline__ int vperm(int s) { return (s & 32) | ((s & 12) << 1) | ((s & 16) >> 2) | (s & 3); }
constexpr int EXTN = 640;
__device__ __forceinline__ void attn_block2(f32x4 (&O)[4], float& mrun, float& lrun, const bf16x8 (&qf)[2], const LAS bf16* Kb, const LAS bf16* Vtb, const LAS float* biasp, int nvalid, int lane) {
    const int fr = lane & 15, fq = lane >> 4;
    f32x4 S[4];
#pragma unroll
    for (int i = 0; i < 4; ++i) S[i] = (f32x4){0.f, 0.f, 0.f, 0.f};
#pragma unroll
    for (int ks = 0; ks < 2; ++ks)
#pragma unroll
        for (int nt = 0; nt < 4; ++nt) { const bf16x8 kf = *(const LAS bf16x8*)(Kb + (nt * 16 + fr) * LP + ks * 32 + 8 * fq);
            S[nt] = __builtin_amdgcn_mfma_f32_16x16x32_bf16(kf, qf[ks], S[nt], 0, 0, 0); }
    float mx = -1e30f;
#pragma unroll
    for (int nt = 0; nt < 4; ++nt)
#pragma unroll
        for (int r = 0; r < 4; ++r) { float s = S[nt][r] * 0.18033688011112042f + biasp[51 - nt * 16 - r];
            if (nvalid < 64 && nt * 16 + 4 * fq + r >= nvalid) s = -1e30f;
            S[nt][r] = s; mx = fmaxf(mx, s); }
    mx = xrow16_max(mx);
    if (__builtin_amdgcn_ballot_w64(mx - mrun > 8.0f) != 0ull) {
        const float mnew = fmaxf(mrun, mx), alpha = __builtin_amdgcn_exp2f(mrun - mnew);
#pragma unroll
        for (int nt = 0; nt < 4; ++nt) O[nt] = O[nt] * alpha;
        lrun *= alpha; mrun = mnew;
    }
    float ps = 0.f;
#pragma unroll
    for (int nt = 0; nt < 4; ++nt)
#pragma unroll
        for (int r = 0; r < 4; ++r) { const float p = __builtin_amdgcn_exp2f(S[nt][r] - mrun); S[nt][r] = p; ps += p; }
    lrun += ps;
    bf16x8 pf[2];
#pragma unroll
    for (int ks = 0; ks < 2; ++ks) { u32x4 w; w.x = pk2(S[2 * ks][0], S[2 * ks][1]); w.y = pk2(S[2 * ks][2], S[2 * ks][3]); w.z = pk2(S[2 * ks + 1][0], S[2 * ks + 1][1]); w.w = pk2(S[2 * ks + 1][2], S[2 * ks + 1][3]);
        pf[ks] = __builtin_bit_cast(bf16x8, w); }
#pragma unroll
    for (int ks = 0; ks < 2; ++ks)
#pragma unroll
        for (int nt = 0; nt < 4; ++nt) { const bf16x8 vf = *(const LAS bf16x8*)(Vtb + (nt * 16 + fr) * LP + ks * 32 + 8 * fq);
            O[nt] = __builtin_amdgcn_mfma_f32_16x16x32_bf16(vf, pf[ks], O[nt], 0, 0, 0); }
}
__device__ __forceinline__ void attn_prompt_unit2(const Params& P, int li, const bf16* PROJ, bf16* MIX, int g, int hp, LAS unsigned char* lds, int tid, int lane, int wave) {
    constexpr int HBUF = 2 * 64 * LP;
    LAS bf16* base = (LAS bf16*)lds; LAS float* ext = (LAS float*)(lds + 4 * HBUF * 2);
    const int n0 = 4 * g, jstart = n0 < 8 ? 8 - n0 : 0;
    const int hh = wave >> 2, sw = wave & 3, h = hp * 2 + hh, fr = lane & 15, fq = lane >> 4;
    for (int i = tid; i < 2 * EXTN; i += NTHR) { const int h2 = i / EXTN, k = i % EXTN; ext[i] = P.in[I_REL][((size_t)li * 8 + hp * 2 + h2) * 320 + (k < 319 ? k : 319)] * 1.4426950408889634f; }
    bf16x8 qf[4][2];
#pragma unroll
    for (int qc = 0; qc < 4; ++qc)
#pragma unroll
        for (int ks = 0; ks < 2; ++ks) qf[qc][ks] = *(const bf16x8*)(PROJ + (size_t)((n0 + qc) * 64 + sw * 16 + fr) * DINO + 512 + h * 64 + ks * 32 + 8 * fq);
    u32x4 kreg[2], vreg[2];
    auto gload = [&](int j) {
        const int kc = n0 - 8 + j;
#pragma unroll
        for (int it = 0; it < 2; ++it) { const int item = tid + it * NTHR;
            { const int eo = item & 7, s = (item >> 3) & 63, h2 = item >> 9; kreg[it] = *(const u32x4*)(PROJ + (size_t)(kc * 64 + s) * DINO + 1024 + (hp * 2 + h2) * 64 + 8 * eo); }
            { const int s = item & 63, eo = (item >> 6) & 7, h2 = item >> 9; vreg[it] = *(const u32x4*)(PROJ + (size_t)(kc * 64 + s) * DINO + 1536 + (hp * 2 + h2) * 64 + 8 * eo); } } };
    auto lstore = [&](int buf) {
#pragma unroll
        for (int it = 0; it < 2; ++it) { const int item = tid + it * NTHR;
            { const int eo = item & 7, s = (item >> 3) & 63, h2 = item >> 9; *(LAS u32x4*)(base + (buf * 2 + h2) * HBUF + s * LP + 8 * eo) = kreg[it]; }
            { const int s = item & 63, eo = (item >> 6) & 7, h2 = item >> 9; LAS bf16* Vt = base + (buf * 2 + h2) * HBUF + 64 * LP + vperm(s);
              const unsigned w[4] = {vreg[it].x, vreg[it].y, vreg[it].z, vreg[it].w};
#pragma unroll
              for (int k = 0; k < 4; ++k) { Vt[(8 * eo + 2 * k) * LP] = (bf16)(w[k] & 0xffffu); Vt[(8 * eo + 2 * k + 1) * LP] = (bf16)(w[k] >> 16); } } } };
    f32x4 O[4][4]; float mrun[4], lrun[4];
#pragma unroll
    for (int qc = 0; qc < 4; ++qc) { mrun[qc] = -1e30f; lrun[qc] = 0.f;
#pragma unroll
        for (int i = 0; i < 4; ++i) O[qc][i] = (f32x4){0.f, 0.f, 0.f, 0.f}; }
    gload(jstart); lstore(jstart & 1);
    __syncthreads();
    for (int j = jstart; j <= 11; ++j) {
        if (j < 11) gload(j + 1);
        const LAS bf16* Kb = base + ((j & 1) * 2 + hh) * HBUF; const LAS bf16* Vtb = Kb + 64 * LP;
#pragma unroll
        for (int qc = 0; qc < 4; ++qc)
            if (qc <= j && j <= qc + 8)
                attn_block2(O[qc], mrun[qc], lrun[qc], qf[qc], Kb, Vtb, ext + hh * EXTN + (qc + 8 - j) * 64 + sw * 16 + 12 + fr - 4 * fq, 64, lane);
        if (j < 11) lstore((j + 1) & 1);
        __syncthreads();
    }
#pragma unroll
    for (int qc = 0; qc < 4; ++qc) { float lt = xrow16_sum(lrun[qc]); const float inv = __builtin_amdgcn_rcpf(lt); const int row = (n0 + qc) * 64 + sw * 16 + fr;
#pragma unroll
        for (int nt = 0; nt < 4; ++nt) { u32x2 w; w.x = pk2(O[qc][nt][0] * inv, O[qc][nt][1] * inv); w.y = pk2(O[qc][nt][2] * inv, O[qc][nt][3] * inv);
            *(u32x2*)(MIX + (size_t)row * D + 512 + h * 64 + nt * 16 + 4 * fq) = w; } }
}
__device__ __forceinline__ void attn_sample_unit2(const Params& P, int li, const bf16* PROJ, bf16* MIX, int b, int hq, LAS unsigned char* lds, int tid, int lane, int wave) {
    constexpr int HB = 2 * 64 * LP;
    LAS bf16* base = (LAS bf16*)lds; LAS float* ext = (LAS float*)(lds + 4 * HB * 2);
    const int row0 = SEQ + b * 16, fr = lane & 15, fq = lane >> 4;
    for (int i = tid; i < 4 * EXTN; i += NTHR) { const int h4 = i / EXTN, k = i % EXTN; ext[i] = P.in[I_REL][((size_t)li * 8 + hq * 4 + h4) * 320 + (k < 319 ? k : 319)] * 1.4426950408889634f; }
    bf16x8 qf[2];
#pragma unroll
    for (int ks = 0; ks < 2; ++ks) qf[ks] = *(const bf16x8*)(PROJ + (size_t)(row0 + fr) * DINO + 512 + (hq * 4 + (wave & 3)) * 64 + ks * 32 + 8 * fq);
    f32x4 O[4];
#pragma unroll
    for (int i = 0; i < 4; ++i) O[i] = (f32x4){0.f, 0.f, 0.f, 0.f};
    float mrun = -1e30f, lrun = 0.f;
    const float* ck = P.in[I_CK] + ((size_t)li * 16 + b) * 512 * 512; const float* cv = P.in[I_CV] + ((size_t)li * 16 + b) * 512 * 512;
    for (int kb = 0; kb <= 8; ++kb) {
        __syncthreads();
#pragma unroll
        for (int it = 0; it < 4; ++it) {
            const int item = tid + it * NTHR; const int eo = item & 7, h4 = (item >> 3) & 3, s = item >> 5; const int hd = hq * 4 + h4;
            float kf[8], vf[8];
            if (kb < 8) {
                const float* kp = ck + (size_t)(kb * 64 + s) * 512 + hd * 64 + 8 * eo; const float* vp = cv + (size_t)(kb * 64 + s) * 512 + hd * 64 + 8 * eo;
                const f32x4 k0 = *(const f32x4*)kp, k1 = *(const f32x4*)(kp + 4), v0 = *(const f32x4*)vp, v1 = *(const f32x4*)(vp + 4);
#pragma unroll
                for (int q = 0; q < 4; ++q) { kf[q] = k0[q]; kf[4 + q] = k1[q]; vf[q] = v0[q]; vf[4 + q] = v1[q]; }
            } else if (s < 16) {
                const bf16* rp = PROJ + (size_t)(row0 + s) * DINO + hd * 64 + 8 * eo;
                const u32x4 kk = *(const u32x4*)(rp + 1024), vv = *(const u32x4*)(rp + 1536);
                const unsigned k4[4] = {kk.x, kk.y, kk.z, kk.w}, v4[4] = {vv.x, vv.y, vv.z, vv.w};
#pragma unroll
                for (int q = 0; q < 4; ++q) { kf[2 * q] = bflo(k4[q]); kf[2 * q + 1] = bfhi(k4[q]); vf[2 * q] = bflo(v4[q]); vf[2 * q + 1] = bfhi(v4[q]); }
            } else {
#pragma unroll
                for (int q = 0; q < 8; ++q) { kf[q] = 0.f; vf[q] = 0.f; }
            }
            u32x4 kw; kw.x = pk2(kf[0], kf[1]); kw.y = pk2(kf[2], kf[3]); kw.z = pk2(kf[4], kf[5]); kw.w = pk2(kf[6], kf[7]);
            *(LAS u32x4*)(base + h4 * HB + s * LP + 8 * eo) = kw;
            LAS bf16* Vt = base + h4 * HB + 64 * LP + vperm(s);
#pragma unroll
            for (int q = 0; q < 8; ++q) Vt[(8 * eo + q) * LP] = f2bf(vf[q]);
        }
        __syncthreads();
        if (wave < 4)
            attn_block2(O, mrun, lrun, qf, base + wave * HB, base + wave * HB + 64 * LP, ext + wave * EXTN + 512 - kb * 64 + 12 + fr - 4 * fq, kb < 8 ? 64 : 16, lane);
    }
    if (wave < 4) {
        const float inv = 1.0f / lrun; const int row = row0 + fr, h = hq * 4 + wave;
#pragma unroll
        for (int nt = 0; nt < 4; ++nt) { u32x2 w; w.x = pk2(O[nt][0] * inv, O[nt][1] * inv); w.y = pk2(O[nt][2] * inv, O[nt][3] * inv);
            *(u32x2*)(MIX + (size_t)row * D + 512 + h * 64 + nt * 16 + 4 * fq) = w; }
    }
    __syncthreads();
}


__device__ __forceinline__ void attn_sample_unit3(const Params& P, int li, const bf16* PROJ, bf16* MIX, int b, int hp, LAS unsigned char* lds, int tid, int lane, int wave) {
    constexpr int HBUF = 2 * 64 * LP;
    LAS bf16* base = (LAS bf16*)lds; LAS float* ext = (LAS float*)(lds + 4 * HBUF * 2);
    const int row0 = SEQ + b * 16, fr = lane & 15, fq = lane >> 4;
    for (int i = tid; i < 2 * EXTN; i += NTHR) { const int h2 = i / EXTN, k = i % EXTN; ext[i] = P.in[I_REL][((size_t)li * 8 + hp * 2 + h2) * 320 + (k < 319 ? k : 319)] * 1.4426950408889634f; }
    bf16x8 qf[2];
#pragma unroll
    for (int ks = 0; ks < 2; ++ks) qf[ks] = *(const bf16x8*)(PROJ + (size_t)(row0 + fr) * DINO + 512 + (hp * 2 + (wave & 1)) * 64 + ks * 32 + 8 * fq);
    const float* ck = P.in[I_CK] + ((size_t)li * 16 + b) * 512 * 512; const float* cv = P.in[I_CV] + ((size_t)li * 16 + b) * 512 * 512;
    f32x4 kr[4], vr[4];
    auto gload = [&](int kb) {
#pragma unroll
        for (int it = 0; it < 2; ++it) { const int item = tid + it * NTHR;
            { const int eo = item & 7, s = (item >> 3) & 63, h2 = item >> 9; const int col = (hp * 2 + h2) * 64 + 8 * eo;
              if (kb < 8) { const float* p = ck + (size_t)(kb * 64 + s) * 512 + col; kr[2 * it] = __builtin_nontemporal_load((const f32x4*)p); kr[2 * it + 1] = __builtin_nontemporal_load((const f32x4*)(p + 4)); }
              else if (s < 16) { const u32x4 w = *(const u32x4*)(PROJ + (size_t)(row0 + s) * DINO + 1024 + col);
                  kr[2 * it] = (f32x4){bflo(w.x), bfhi(w.x), bflo(w.y), bfhi(w.y)}; kr[2 * it + 1] = (f32x4){bflo(w.z), bfhi(w.z), bflo(w.w), bfhi(w.w)}; }
              else { kr[2 * it] = (f32x4){0.f, 0.f, 0.f, 0.f}; kr[2 * it + 1] = kr[2 * it]; } }
            { const int s = item & 63, eo = (item >> 6) & 7, h2 = item >> 9; const int col = (hp * 2 + h2) * 64 + 8 * eo;
              if (kb < 8) { const float* p = cv + (size_t)(kb * 64 + s) * 512 + col; vr[2 * it] = __builtin_nontemporal_load((const f32x4*)p); vr[2 * it + 1] = __builtin_nontemporal_load((const f32x4*)(p + 4)); }
              else if (s < 16) { const u32x4 w = *(const u32x4*)(PROJ + (size_t)(row0 + s) * DINO + 1536 + col);
                  vr[2 * it] = (f32x4){bflo(w.x), bfhi(w.x), bflo(w.y), bfhi(w.y)}; vr[2 * it + 1] = (f32x4){bflo(w.z), bfhi(w.z), bflo(w.w), bfhi(w.w)}; }
              else { vr[2 * it] = (f32x4){0.f, 0.f, 0.f, 0.f}; vr[2 * it + 1] = vr[2 * it]; } } } };
    auto lstore = [&](int buf) {
#pragma unroll
        for (int it = 0; it < 2; ++it) { const int item = tid + it * NTHR;
            { const int eo = item & 7, s = (item >> 3) & 63, h2 = item >> 9; const f32x4 a = kr[2 * it], c = kr[2 * it + 1];
              u32x4 w; w.x = pk2(a[0], a[1]); w.y = pk2(a[2], a[3]); w.z = pk2(c[0], c[1]); w.w = pk2(c[2], c[3]);
              *(LAS u32x4*)(base + (buf * 2 + h2) * HBUF + s * LP + 8 * eo) = w; }
            { const int s = item & 63, eo = (item >> 6) & 7, h2 = item >> 9; LAS bf16* Vt = base + (buf * 2 + h2) * HBUF + 64 * LP + vperm(s);
              const f32x4 a = vr[2 * it], c = vr[2 * it + 1];
#pragma unroll
              for (int q = 0; q < 4; ++q) { Vt[(8 * eo + q) * LP] = f2bf(a[q]); Vt[(8 * eo + 4 + q) * LP] = f2bf(c[q]); } } } };
    f32x4 O[4];
#pragma unroll
    for (int i = 0; i < 4; ++i) O[i] = (f32x4){0.f, 0.f, 0.f, 0.f};
    float mrun = -1e30f, lrun = 0.f;
    gload(0); lstore(0);
    __syncthreads();
    for (int kb = 0; kb <= 8; ++kb) {
        if (kb < 8) gload(kb + 1);
        if (wave < 2) {
            const LAS bf16* Kb = base + ((kb & 1) * 2 + wave) * HBUF;
            attn_block2(O, mrun, lrun, qf, Kb, Kb + 64 * LP, ext + wave * EXTN + 512 - kb * 64 + 12 + fr - 4 * fq, kb < 8 ? 64 : 16, lane);
        }
        if (kb < 8) lstore((kb + 1) & 1);
        __syncthreads();
    }
    if (wave < 2) {
        float lt = xrow16_sum(lrun); const float inv = __builtin_amdgcn_rcpf(lt); const int row = row0 + fr, h = hp * 2 + wave;
#pragma unroll
        for (int nt = 0; nt < 4; ++nt) { u32x2 w; w.x = pk2(O[nt][0] * inv, O[nt][1] * inv); w.y = pk2(O[nt][2] * inv, O[nt][3] * inv);
            *(u32x2*)(MIX + (size_t)row * D + 512 + h * 64 + nt * 16 + 4 * fq) = w; }
    }
}

__device__ __forceinline__ void pool_unit(const Params& P, int li, const bf16* PROJ, const bf16* PWt, bf16* MIX, int rt, int g, LAS unsigned char* lds, int tid, int lane, int wave) {
    constexpr int PP = 136;
    LAS bf16* A = (LAS bf16*)lds; LAS bf16* Bt = A + 64 * PP;
    const bf16* pw = PWt + ((size_t)li * 4 + g) * 128 * 128;
#pragma unroll
    for (int it = 0; it < 4; ++it) { const int item = tid + it * NTHR; const int co = item & 15, d = item >> 4;
        *(LAS u32x4*)(Bt + d * PP + 8 * co) = *(const u32x4*)(pw + d * 128 + 8 * co); }
    {
        const int c = tid & 127, rq = tid >> 7;
        const int m0 = rt * 64 + rq * 16;
        const bool samp = m0 >= SEQ; const int b = samp ? (m0 - SEQ) >> 4 : 0;
        const int t0 = samp ? 0 : m0;
        const bf16* colp = PROJ + (size_t)m0 * DINO + g * 128 + c;
        const float* sp = P.in[I_SPOOL] + ((size_t)li * 16 + b) * 15 * 512 + g * 128 + c;
        float xv[31];
#pragma unroll
        for (int i = 15; i < 31; ++i) xv[i] = bf2f(colp[(ptrdiff_t)(i - 15) * DINO]);
        if (samp) {
#pragma unroll
            for (int i = 0; i < 15; ++i) xv[i] = sp[(size_t)i * 512];
        } else {
#pragma unroll
            for (int i = 0; i < 15; ++i) { const int tl = t0 - 15 + i; const float v = bf2f(colp[(ptrdiff_t)((tl >= 0 ? tl : 0) - t0) * DINO]); xv[i] = tl >= 0 ? v : 0.f; }
        }
        const int w = 2 << g;
        float ps[32]; ps[0] = 0.f;
#pragma unroll
        for (int j = 0; j < 31; ++j) ps[j + 1] = ps[j] + xv[j];
        float ws[16];
        if (g == 0) {
#pragma unroll
            for (int k = 0; k < 16; ++k) ws[k] = ps[16 + k] - ps[14 + k];
        } else if (g == 1) {
#pragma unroll
            for (int k = 0; k < 16; ++k) ws[k] = ps[16 + k] - ps[12 + k];
        } else if (g == 2) {
#pragma unroll
            for (int k = 0; k < 16; ++k) ws[k] = ps[16 + k] - ps[8 + k];
        } else {
#pragma unroll
            for (int k = 0; k < 16; ++k) ws[k] = ps[16 + k] - ps[k];
        }
#pragma unroll
        for (int k = 0; k < 16; ++k) {
            const int tl = t0 + k;
            const float cnt = samp ? (float)w : (float)(tl + 1 < w ? tl + 1 : w);
            A[(rq * 16 + k) * PP + c] = f2bf(ws[k] * __builtin_amdgcn_rcpf(cnt) - xv[15 + k]);
        }
    }
    __syncthreads();
    {
        const int strip = wave & 3, ch = wave >> 2, fr = lane & 15, fq = lane >> 4;
        f32x4 acc[4];
#pragma unroll
        for (int i = 0; i < 4; ++i) acc[i] = (f32x4){0.f, 0.f, 0.f, 0.f};
        wave_mm<4, 4>(acc, A + strip * 16 * PP, PP, Bt + ch * 64 * PP, PP, lane);
        const int row = rt * 64 + strip * 16 + fr;
        const float* ps = P.in[I_POOLS] + (size_t)li * 512 + g * 128 + ch * 64;
#pragma unroll
        for (int nt = 0; nt < 4; ++nt) { const f32x4 sc = *(const f32x4*)(ps + nt * 16 + 4 * fq);
            u32x2 w; w.x = pk2(acc[nt][0] * sc[0], acc[nt][1] * sc[1]); w.y = pk2(acc[nt][2] * sc[2], acc[nt][3] * sc[3]);
            *(u32x2*)(MIX + (size_t)row * D + g * 128 + ch * 64 + nt * 16 + 4 * fq) = w; }
    }
    __syncthreads();
}

__device__ __forceinline__ void convgate_items(const Params& P, int l, const bf16* UP, bf16* ACT, int gtid, int GT) {
    const float* cw = P.in[I_FCONV] + (size_t)l * 3 * DUP;
    constexpr int NCO = DFF / 8, NRB = M / 8;
    for (int item = gtid; item < NRB * NCO; item += GT) {
        const int co = item % NCO, rb = item / NCO, c = 8 * co, m0 = rb * 8;
        const bool samp = m0 >= SEQ; const int b = samp ? (m0 - SEQ) >> 4 : 0; const int t0 = samp ? (m0 - SEQ) & 15 : m0;
        float wa[3][8], wb[3][8];
#pragma unroll
        for (int j = 0; j < 3; ++j)
#pragma unroll
            for (int q = 0; q < 8; ++q) { wa[j][q] = cw[j * DUP + c + q]; wb[j][q] = cw[j * DUP + DFF + c + q]; }
        float ua[3][8], ub[3][8];
        u32x4 ra[10], rbv[10];
#pragma unroll
        for (int k = 0; k < 10; ++k) {
            const bf16* rp = UP + (size_t)((k < 2 && t0 == 0) ? m0 : m0 - 2 + k) * DUP + c;
            ra[k] = *(const u32x4*)rp; rbv[k] = *(const u32x4*)(rp + DFF);
        }
#pragma unroll
        for (int k = 0; k < 2; ++k) {
            const unsigned a4[4] = {ra[k].x, ra[k].y, ra[k].z, ra[k].w}, b4[4] = {rbv[k].x, rbv[k].y, rbv[k].z, rbv[k].w};
#pragma unroll
            for (int q = 0; q < 4; ++q) { ua[k][2 * q] = t0 > 0 ? bflo(a4[q]) : 0.f; ua[k][2 * q + 1] = t0 > 0 ? bfhi(a4[q]) : 0.f; ub[k][2 * q] = t0 > 0 ? bflo(b4[q]) : 0.f; ub[k][2 * q + 1] = t0 > 0 ? bfhi(b4[q]) : 0.f; }
        }
        if (samp && t0 == 0) {
#pragma unroll
            for (int k = 0; k < 2; ++k) { const float* sp = P.in[I_SFFN] + (((size_t)l * 16 + b) * 2 + k) * DUP + c;
#pragma unroll
                for (int q = 0; q < 8; ++q) { ua[k][q] = sp[q]; ub[k][q] = sp[DFF + q]; } }
        }
#pragma unroll
        for (int r = 0; r < 8; ++r) {
            const unsigned a4[4] = {ra[r + 2].x, ra[r + 2].y, ra[r + 2].z, ra[r + 2].w}, b4[4] = {rbv[r + 2].x, rbv[r + 2].y, rbv[r + 2].z, rbv[r + 2].w};
#pragma unroll
            for (int q = 0; q < 4; ++q) { ua[2][2 * q] = bflo(a4[q]); ua[2][2 * q + 1] = bfhi(a4[q]); ub[2][2 * q] = bflo(b4[q]); ub[2][2 * q + 1] = bfhi(b4[q]); }
            float y[8];
#pragma unroll
            for (int q = 0; q < 8; ++q) {
                const float av = wa[0][q] * ua[0][q] + wa[1][q] * ua[1][q] + wa[2][q] * ua[2][q];
                const float bv = wb[0][q] * ub[0][q] + wb[1][q] * ub[1][q] + wb[2][q] * ub[2][q];
                y[q] = silu_f(av) * bv;
                ua[0][q] = ua[1][q]; ua[1][q] = ua[2][q]; ub[0][q] = ub[1][q]; ub[1][q] = ub[2][q];
            }
            u32x4 o; o.x = pk2(y[0], y[1]); o.y = pk2(y[2], y[3]); o.z = pk2(y[4], y[5]); o.w = pk2(y[6], y[7]);
            *(u32x4*)(ACT + (size_t)(m0 + r) * DFF + c) = o;
        }
    }
}


#define XB_TMO      128
#define XB_XCNT(j)  (256  + 64 * (j))
#define XB_XSUB(j)  (1280 + 64 * (j))
#define XB_XGEN(j)  (2304 + 64 * (j))
#define XB_TOP      3328
#define XB_TOPGEN   3392
#define XCD_BAR_WORDS 3456
#define XB_SPIN_CAP (1u << 18)

__device__ __forceinline__ unsigned xb_ld(unsigned* p)              { return __hip_atomic_load(p, __ATOMIC_RELAXED, __HIP_MEMORY_SCOPE_AGENT); }
__device__ __forceinline__ unsigned xb_add(unsigned* p, unsigned v) { return __hip_atomic_fetch_add(p, v, __ATOMIC_RELAXED, __HIP_MEMORY_SCOPE_AGENT); }
__device__ __forceinline__ unsigned xb_xcc_id() { return (unsigned)__builtin_amdgcn_s_getreg((3 << 11) | 20) & 0xFu; }
#define XB_SPIN(cond, bar) do { unsigned _sp = 0; while (cond) { __builtin_amdgcn_s_sleep(1); \
    if ((++_sp & 255u) == 0u) { if (xb_ld(&(bar)[XB_TMO])) break; if (_sp > XB_SPIN_CAP) { atomicAdd(&(bar)[XB_TMO], 1u); break; } } } } while (0)

struct XcdBarrier {
    unsigned* bar; unsigned x;
    volatile LAS unsigned* st;
};

__device__ __forceinline__ XcdBarrier xcd_barrier_post(unsigned* bar, volatile LAS unsigned* st) {
    XcdBarrier b; b.bar = bar; b.x = xb_xcc_id(); b.st = st;
    if (threadIdx.x == 0) (void)xb_add(&bar[XB_XCNT(b.x)], 1u);
    return b;
}
__device__ __forceinline__ void xcd_barrier_complete(unsigned* bar, unsigned x, unsigned& nloc, unsigned& nx) {
    const unsigned G = gridDim.x * gridDim.y * gridDim.z;
    unsigned sum, cnt, mine, sp = 0u;
    for (;;) {
        sum = 0u; cnt = 0u; mine = 0u;
#pragma unroll
        for (unsigned j = 0; j < 16; ++j) { const unsigned c = xb_ld(&bar[XB_XCNT(j)]); sum += c; cnt += (c > 0u) ? 1u : 0u; mine = (j == x) ? c : mine; }
        if (sum == G) break;
        __builtin_amdgcn_s_sleep(1);
        if ((++sp & 255u) == 0u) { if (xb_ld(&bar[XB_TMO])) break; if (sp > XB_SPIN_CAP) { atomicAdd(&bar[XB_TMO], 1u); break; } }
    }
    nloc = mine > 0u ? mine : 1u; nx = cnt > 0u ? cnt : 1u;
}

__device__ __forceinline__ void xcd_barrier(const XcdBarrier& b) {
    asm volatile("s_waitcnt vmcnt(0)" ::: "memory");
    __syncthreads();
    if (threadIdx.x == 0) {
        unsigned* bar = b.bar;
        __builtin_amdgcn_s_waitcnt(0);
        unsigned nloc = b.st[0], nx = b.st[1];
        if (nloc == 0u) { xcd_barrier_complete(bar, b.x, nloc, nx); b.st[0] = nloc; b.st[1] = nx; }
        const unsigned old = xb_add(&bar[XB_XSUB(b.x)], 1u);
        const unsigned gen = old / nloc;
        if (old + 1u == (gen + 1u) * nloc) {
            __builtin_amdgcn_fence(__ATOMIC_RELEASE, "agent");
            asm volatile("s_waitcnt vmcnt(0)" ::: "memory");
            const unsigned og = xb_add(&bar[XB_TOP], 1u);
            const unsigned tg = og / nx;
            if (og + 1u == (tg + 1u) * nx) xb_add(&bar[XB_TOPGEN], 1u);
            else XB_SPIN(xb_ld(&bar[XB_TOPGEN]) == tg, bar);
            __builtin_amdgcn_fence(__ATOMIC_ACQUIRE, "agent");
            xb_add(&bar[XB_XGEN(b.x)], 1u);
            asm volatile("s_waitcnt vmcnt(0)" ::: "memory");
        } else {
            XB_SPIN(xb_ld(&bar[XB_XGEN(b.x)]) == gen, bar);
            __builtin_amdgcn_fence(__ATOMIC_ACQUIRE, "agent");
            asm volatile("s_waitcnt vmcnt(0)" ::: "memory");
        }
    }
    __syncthreads();
}
__global__ void __launch_bounds__(NTHR) mega_fwd(Params P) {
    extern __shared__ __attribute__((aligned(16))) unsigned char lds_raw[];
    cg::grid_group grid = cg::this_grid();
    LAS unsigned char* lds = (LAS unsigned char*)lds_raw;
    const int G = gridDim.x, bx = blockIdx.x;
    const int NGW = G * NWAVES, GT = G * NTHR;
    unsigned char* ws = P.ws;
    bf16* HM = (bf16*)(ws + WS_HM); bf16* MIX = (bf16*)(ws + WS_MIX); bf16* ACT = (bf16*)(ws + WS_HM);
    bf16* R1 = (bf16*)(ws + WS_R1); float* KVS = (float*)(ws + WS_KVS);
    float* MOD = (float*)(ws + WS_MOD); const f32x2* rope = (const f32x2*)(ws + WS_ROPE);
    float* X = P.out;
    volatile LAS unsigned* MISC = (volatile LAS unsigned*)(lds + 131072 + 512);
    unsigned* barw = (unsigned*)(ws + WS_CTL);
    if (threadIdx.x < 2) MISC[threadIdx.x] = 0u;
    if (bx == 0) for (int i = threadIdx.x; i < XCD_BAR_WORDS; i += NTHR) barw[i] = 0u;
    __syncthreads();

    { PHASE_IDS phase0(P, lds, tid, lane, wave); }
    grid.sync();
    const XcdBarrier xbar = xcd_barrier_post(barw, MISC);

    for (int l = 0; l < 4; ++l) {
        const int li = l >> 1; const bool even = (l & 1) == 0;
        const float* modl = MOD + (size_t)l * NBT * MODW;
        for (int half = 0; half < 2; ++half) {
            const bool first = (l == 0 && half == 0);
            const float* xp = first ? P.in[I_XP] : X; const float* xs = first ? P.in[I_XS] : X + (size_t)SEQ * D;
            { PHASE_IDS norm_phase(xp, xs, (half == 0 ? P.in[I_NMIX] : P.in[I_NFFN]) + (size_t)l * D, modl, half * 3072, half * 3072 + 1024, HM, gw, NGW, lane); }
            xcd_barrier(xbar);
            {
                const int N = half == 1 ? DUP : (even ? DINE : DINO);
                const bf16* Wt = half == 1 ? (const bf16*)(ws + WS_WUP) + (size_t)l * DUP * D
                                           : (even ? (const bf16*)(ws + WS_WINE) + (size_t)li * DINE * D : (const bf16*)(ws + WS_WINO) + (size_t)li * DINO * D);
                const bool split = (half == 0 && !even);
                const int Mg = split ? SEQ : M;
                pg8::Gemm g{HM, Wt, Mg, N, D}; pg8::StaticOrder S; S.init(Mg, N, G, bx);
                EpiBf E{R1, N, half == 1 ? 2 : (even ? 0 : 1), half == 1 ? l : li, P.out};
                pg8::gemm_phase<EpiBf, pg8::StaticOrder, true, true>(lds, g, S, E);
                if (split) { PHASE_IDS
                    float* outp = P.out; bf16* PR = R1;
                    small_gemm(HM + (size_t)SEQ * D, Wt, DINO, D, lds, bx, G, tid, lane, wave, [=](int sr, int c, float s0, float s1) {
                        const int b = sr >> 4, t = sr & 15;
                        *(unsigned*)(PR + (size_t)(SEQ + sr) * DINO + c) = pk2(s0, s1);
                        float* dst = nullptr;
                        if (c < 512) { if (t >= 1) dst = outp + O_POOLS + (((size_t)li * 16 + b) * 15 + (t - 1)) * 512 + c; }
                        else if (c >= 1536) dst = outp + O_VS + (((size_t)li * 16 + b) * 16 + t) * 512 + (c - 1536);
                        else if (c >= 1024) dst = outp + O_KS + (((size_t)li * 16 + b) * 16 + t) * 512 + (c - 1024);
                        if (dst) *(f32x2*)dst = (f32x2){s0, s1};
                    });
                }
            }
            xcd_barrier(xbar);
            if (half == 0) {
                if (even) {
                    { PHASE_IDS
                    kv_units_pipelined(R1, rope, KVS, bx, G, lds, tid, lane, wave);
                    sconv_items(P, li, R1, MIX, gtid, GT); }
                    xcd_barrier(xbar);
                    { PHASE_IDS for (int w = bx; w < 256; w += G) scan_task(KVS, P.out + O_RETP + (size_t)li * 32768, w, lds, tid); }
                    xcd_barrier(xbar);
                    { PHASE_IDS
                    retout_units_pipelined(P, li, R1, rope, KVS, MIX, bx, G, lds, tid, lane, wave);
                    for (int u = bx + ((1024 - bx + G - 1) / G) * G; u < 1024 + 128; u += G) retstep_unit(P, li, R1, rope, MIX, (u - 1024) >> 3, (u - 1024) & 7, lds, tid, lane, wave);
                    }
                } else {
                    { PHASE_IDS
                    const int nsplit = G > 128 ? 64 : 0;
                    if (bx < nsplit || nsplit == 0) for (int u = bx; u < 64; u += (nsplit ? nsplit : G)) attn_sample_unit3(P, li, R1, MIX, u >> 2, u & 3, lds, tid, lane, wave);
                    if (bx >= nsplit) for (int u = bx - nsplit; u < 1040; u += G - nsplit) pool_unit(P, li, R1, (const bf16*)(ws + WS_POOLW), MIX, u >> 2, u & 3, lds, tid, lane, wave);
                    for (int u = bx; u < 256; u += G) attn_prompt_unit2(P, li, R1, MIX, u >> 2, u & 3, lds, tid, lane, wave);
                    }
                }
            } else {
                { PHASE_IDS convgate_items(P, l, R1, ACT, gtid, GT); }
            }
            xcd_barrier(xbar);
            {
                const int K = half == 1 ? DFF : D;
                const bf16* A = half == 1 ? ACT : MIX;
                const bf16* Wt = half == 1 ? (const bf16*)(ws + WS_WDN) + (size_t)l * D * DFF
                                           : (even ? (const bf16*)(ws + WS_WOUTE) + (size_t)li * D * D : (const bf16*)(ws + WS_WOUTO) + (size_t)li * D * D);
                pg8::Gemm g{A, Wt, SEQ, D, K}; pg8::StaticOrder S; S.init(SEQ, D, G, bx);
                EpiRes E{xp, xs, X, modl + half * 3072 + 2048};
                pg8::gemm_phase<EpiRes, pg8::StaticOrder, true, true>(lds, g, S, E);
                { PHASE_IDS
                    const float* gate = modl + half * 3072 + 2048; float* Xs = X + (size_t)SEQ * D;
                    small_gemm(A + (size_t)SEQ * K, Wt, D, K, lds, bx, G, tid, lane, wave, [=](int sr, int c, float s0, float s1) {
                        const float* g2 = gate + (1 + (sr >> 4)) * MODW + c; const float* bp = xs + (size_t)sr * D + c;
                        *(f32x2*)(Xs + (size_t)sr * D + c) = (f32x2){bp[0] + g2[0] * s0, bp[1] + g2[1] * s1};
                    });
                }
            }
            xcd_barrier(xbar);
        }
    }
    { PHASE_IDS final_norm_phase(X, P.in[I_NFIN], gw, NGW, lane); }
}

extern "C" void kernel_launch(void* const* d_in, const int* in_sizes, int n_in, void* d_out, int out_size, void* d_ws, size_t ws_size, hipStream_t stream) {
    static int grid = 0;
    if (grid == 0) {
        if (n_in != 27 || (size_t)out_size != O_END || ws_size < WS_END) { fprintf(stderr, "kernel_launch: unexpected shapes: n_in %d out %d ws %zu (need %zu)\n", n_in, out_size, ws_size, (size_t)WS_END); grid = -1; return; }
        int dev = 0, cus = 0, per_cu = 0;
        hipGetDevice(&dev); hipDeviceGetAttribute(&cus, hipDeviceAttributeMultiprocessorCount, dev);
        hipFuncSetAttribute((const void*)mega_fwd, hipFuncAttributeMaxDynamicSharedMemorySize, LDS_BYTES);
        hipOccupancyMaxActiveBlocksPerMultiprocessor(&per_cu, (const void*)mega_fwd, NTHR, LDS_BYTES);
        if (per_cu < 1) per_cu = 1;
        grid = cus;
        (void)hipGetLastError();
    }
    if (grid < 0) return;
    Params p{};
    for (int i = 0; i < 27; ++i) p.in[i] = (const float*)d_in[i];
    p.out = (float*)d_out; p.ws = (unsigned char*)d_ws;
    void* args[] = {&p};
    hipError_t e = hipLaunchCooperativeKernel((const void*)mega_fwd, dim3(grid), dim3(NTHR), args, LDS_BYTES, stream);
    if (e != hipSuccess) fprintf(stderr, "cooperative launch failed: %s (grid %d)\n", hipGetErrorString(e), grid);
}
```

```cpp
#include <hip/hip_runtime.h>
#include <hip/hip_cooperative_groups.h>
#include <cstdio>
#include <cstdint>
namespace cg = cooperative_groups;
namespace pg8 {
#define PG8_LAS __attribute__((address_space(3)))
typedef unsigned short bf16_t;
typedef short bf16x8 __attribute__((ext_vector_type(8)));
typedef float f32x4 __attribute__((ext_vector_type(4)));
typedef unsigned u32x4 __attribute__((ext_vector_type(4)));
constexpr int BM = 256, BK = 64, HALF = 128, HTB = HALF * BK * 2  , STAGE_BYTES = 8 * HTB, NXCD = 8, WGM = 4;

__host__ __device__ __forceinline__ int lds_byte(int r, int c) { const int st = (r >> 4) * 2 + (c >> 5), rr = r & 15, cc = c & 31, ob = rr * 64 + cc * 2; return st * 1024 + (ob ^ (((ob >> 9) & 1) << 5)); }
__host__ __device__ __forceinline__ void stage_rc(int b, int& R, int& C) { const int st = b / 1024, sb = b % 1024, swz = sb ^ (((sb >> 9) & 1) << 5); R = (st >> 1) * 16 + swz / 64; C = (st & 1) * 32 + (swz % 64) / 2; }
__host__ __device__ __forceinline__ int perm32(int rho) { const int n = rho >> 4, i = rho & 15; return 8 * (i >> 2) + 4 * n + (i & 3); }

struct Unit { int pm, pn; };
struct Gemm { const bf16_t* A; const bf16_t* Bt; int M, N, K; };

struct StaticOrder {
    int nM, nN, nwg, G, c;
    __host__ __device__ void init(int M, int N, int G_, int c_) { nM = M / BM; nN = N / BM; nwg = nM * nN; G = G_; c = c_; }
    __host__ __device__ bool next(int i, Unit& u) const {
        const long L = (long)i * G + c; if (L >= nwg) return false;
        int wgid = (int)L; { const int q = nwg / NXCD, r = nwg % NXCD, xcd = wgid % NXCD, off = wgid / NXCD; wgid = (xcd < r ? xcd * (q + 1) : r * (q + 1) + (xcd - r) * q) + off; }
        const int nig = WGM * nN, gid = wgid / nig, fm = gid * WGM, gsz = (nM - fm) < WGM ? (nM - fm) : WGM;
        u.pm = fm + ((wgid % nig) % gsz); u.pn = (wgid % nig) / gsz; return true;
    }
    __device__ __forceinline__ void a_ready(const Unit&) const {}
    __device__ __forceinline__ void done(const Unit&) const {}
};

__device__ __forceinline__ unsigned cvt_pk_bf16(float lo, float hi) { unsigned r; asm volatile("v_cvt_pk_bf16_f32 %0, %1, %2" : "=v"(r) : "v"(lo), "v"(hi)); return r; }
template <class Epi, class Sched, bool ALIGN_EPI = false, bool SP2 = false>
__device__ __forceinline__ void gemm_phase(PG8_LAS unsigned char* lds, const Gemm g, const Sched& S, const Epi& E) {
    int tid; asm volatile("v_mov_b32 %0, %1" : "=v"(tid) : "v"((int)threadIdx.x));
    const int wid = __builtin_amdgcn_readfirstlane(tid >> 6), lane = tid & 63, wr = wid >> 2, wc = wid & 3, fr = lane & 15, fq = lane >> 4;
    const int K = g.K, nt = K / BK;
    unsigned voffA[2], voffB[2];
#pragma unroll
    for (int i = 0; i < 2; ++i) { int R, C; stage_rc(tid * 16 + i * 8192, R, C); const int Rb = Epi::PERM ? ((R & ~31) + perm32(R & 31)) : R;
        voffA[i] = (unsigned)(R * K + C) * 2u; voffB[i] = (unsigned)(Rb * K + C) * 2u; }
    const size_t kstep = (size_t)(BK * 2);
    const size_t hstep = (size_t)HALF * K * 2;
    const size_t tstep = 2 * hstep;
    const unsigned ldsw = (unsigned)wid * 1024u;
    const int aoff = lds_byte(wr * 64 + fr, fq * 8), boff = lds_byte(wc * 32 + fr, fq * 8);
#define PG8_SA(b, h) (((b) * 2 + (h)) * HTB)
#define PG8_SB(b, h) ((4 + (b) * 2 + (h)) * HTB)
#define PG8_STAGE(bufoff, gbase, voff) do { _Pragma("unroll") for (int _i = 0; _i < 2; ++_i) \
        __builtin_amdgcn_global_load_lds((const unsigned*)((const char*)(gbase) + (voff)[_i]), (PG8_LAS unsigned*)(lds + (bufoff) + ldsw + _i * 8192), 16, 0, 0); } while (0)
#define PG8_LDA(dst, b, h) do { _Pragma("unroll") for (int m = 0; m < 4; ++m) _Pragma("unroll") for (int k = 0; k < 2; ++k) dst[m][k] = *(const PG8_LAS bf16x8*)(lds + PG8_SA(b, h) + aoff + m * 2048 + k * 1024); } while (0)
#define PG8_LDB(dst, b, h) do { _Pragma("unroll") for (int n = 0; n < 2; ++n) _Pragma("unroll") for (int k = 0; k < 2; ++k) dst[n][k] = *(const PG8_LAS bf16x8*)(lds + PG8_SB(b, h) + boff + n * 2048 + k * 1024); } while (0)
#define PG8_MMA(ai, bj, At, Bt) do { __builtin_amdgcn_s_setprio(1); _Pragma("unroll") for (int m = 0; m < 4; ++m) _Pragma("unroll") for (int n = 0; n < 2; ++n) _Pragma("unroll") for (int k = 0; k < 2; ++k) \
        acc[ai][bj][m][n] = __builtin_amdgcn_mfma_f32_16x16x32_bf16(Bt[n][k], At[m][k], acc[ai][bj][m][n], 0, 0, 0); __builtin_amdgcn_s_setprio(0); } while (0)
#define PG8_WAIT_V(n) asm volatile("s_waitcnt vmcnt(" #n ")" ::: "memory")
#define PG8_WAIT_L(n) asm volatile("s_waitcnt lgkmcnt(" #n ")" ::: "memory")
#define PG8_BAR __builtin_amdgcn_s_barrier()
#define PG8_SCHED __builtin_amdgcn_sched_barrier(0)
    Unit cur, nxt; int ui = 0;
    if (!S.next(0, cur)) return;
    f32x4 acc[2][2][4][2];
#pragma unroll
    for (int a = 0; a < 2; ++a)
#pragma unroll
        for (int b = 0; b < 2; ++b)
#pragma unroll
            for (int m = 0; m < 4; ++m)
#pragma unroll
                for (int n = 0; n < 2; ++n) acc[a][b][m][n] = (f32x4){0.f, 0.f, 0.f, 0.f};
    bf16x8 At[4][2], B0[2][2], B1[2][2];
    const char* cA = (const char*)g.A + (size_t)cur.pm * tstep; const char* cB = (const char*)g.Bt + (size_t)cur.pn * tstep;
    S.a_ready(cur);
    if constexpr (SP2) {
        PG8_STAGE(PG8_SB(0, 0), cB, voffB); PG8_STAGE(PG8_SB(0, 1), cB + hstep, voffB); PG8_STAGE(PG8_SA(0, 0), cA, voffA); PG8_STAGE(PG8_SA(0, 1), cA + hstep, voffA);
        if (wr == 1) PG8_BAR;
        PG8_WAIT_V(2); PG8_BAR;
        PG8_STAGE(PG8_SB(1, 0), cB + kstep, voffB); PG8_STAGE(PG8_SA(1, 0), cA + kstep, voffA); PG8_STAGE(PG8_SB(1, 1), cB + hstep + kstep, voffB);
        PG8_WAIT_V(6); PG8_BAR;
    } else {
        PG8_STAGE(PG8_SB(0, 0), cB, voffB); PG8_STAGE(PG8_SA(0, 0), cA, voffA); PG8_STAGE(PG8_SB(0, 1), cB + hstep, voffB); PG8_STAGE(PG8_SA(0, 1), cA + hstep, voffA);
        if (wr == 1) PG8_BAR;
        PG8_WAIT_V(4); PG8_BAR;
        PG8_STAGE(PG8_SB(1, 0), cB + kstep, voffB); PG8_STAGE(PG8_SA(1, 0), cA + kstep, voffA); PG8_STAGE(PG8_SB(1, 1), cB + hstep + kstep, voffB);
        PG8_WAIT_V(6); PG8_BAR;
    }
    for (;;) {
        const bool has_next = S.next(ui + 1, nxt);
        const char* nA = has_next ? (const char*)g.A + (size_t)nxt.pm * tstep : cA; const char* nB = has_next ? (const char*)g.Bt + (size_t)nxt.pn * tstep : cB;
        for (int t = 0; t < nt; t += 2) {
            const bool last = (t == nt - 2);
            const char* a1 = cA + (size_t)(t + 1) * kstep;
            const char* a2 = last ? nA : cA + (size_t)(t + 2) * kstep; const char* b2 = last ? nB : cB + (size_t)(t + 2) * kstep;
            const char* a3 = a2 + kstep; const char* b3 = b2 + kstep;
            if (last && has_next) S.a_ready(nxt);
            if constexpr (SP2) {
            PG8_LDB(B0, 0, 0); PG8_LDB(B1, 0, 1); PG8_SCHED; PG8_LDA(At, 0, 0); PG8_STAGE(PG8_SA(1, 1), a1 + hstep, voffA);
            PG8_WAIT_V(8); PG8_WAIT_L(0); PG8_BAR; PG8_MMA(0, 0, At, B0); PG8_MMA(0, 1, At, B1); PG8_BAR; PG8_SCHED;
            PG8_LDA(At, 0, 1); PG8_STAGE(PG8_SB(0, 0), b2, voffB); PG8_STAGE(PG8_SB(0, 1), b2 + hstep, voffB); PG8_STAGE(PG8_SA(0, 0), a2, voffA);
            PG8_WAIT_V(8); PG8_WAIT_L(0); PG8_BAR; PG8_MMA(1, 0, At, B0); PG8_MMA(1, 1, At, B1); PG8_BAR; PG8_SCHED;
            PG8_LDB(B0, 1, 0); PG8_LDB(B1, 1, 1); PG8_SCHED; PG8_LDA(At, 1, 0); PG8_STAGE(PG8_SA(0, 1), a2 + hstep, voffA);
            PG8_WAIT_V(8); PG8_WAIT_L(0); PG8_BAR; PG8_MMA(0, 0, At, B0); PG8_MMA(0, 1, At, B1); PG8_BAR; PG8_SCHED;
            PG8_LDA(At, 1, 1); PG8_STAGE(PG8_SB(1, 0), b3, voffB); PG8_STAGE(PG8_SB(1, 1), b3 + hstep, voffB); PG8_STAGE(PG8_SA(1, 0), a3, voffA);
            PG8_WAIT_V(8); PG8_WAIT_L(0); PG8_BAR; PG8_MMA(1, 0, At, B0); PG8_MMA(1, 1, At, B1); PG8_BAR; PG8_SCHED;
            } else {
            PG8_LDB(B0, 0, 0); PG8_SCHED; PG8_LDA(At, 0, 0); PG8_STAGE(PG8_SA(1, 1), a1 + hstep, voffA);
            PG8_WAIT_L(8); PG8_BAR; PG8_WAIT_L(0); PG8_MMA(0, 0, At, B0); PG8_BAR; PG8_SCHED;
            PG8_LDB(B1, 0, 1); PG8_STAGE(PG8_SB(0, 0), b2, voffB);
            PG8_BAR; PG8_WAIT_L(0); PG8_MMA(0, 1, At, B1); PG8_BAR;
            PG8_LDA(At, 0, 1); PG8_STAGE(PG8_SA(0, 0), a2, voffA);
            PG8_BAR; PG8_WAIT_L(0); PG8_MMA(1, 0, At, B0); PG8_BAR; PG8_SCHED;
            PG8_STAGE(PG8_SB(0, 1), b2 + hstep, voffB);
            PG8_WAIT_V(6); PG8_BAR; PG8_MMA(1, 1, At, B1); PG8_BAR;
            PG8_LDB(B0, 1, 0); PG8_SCHED; PG8_LDA(At, 1, 0); PG8_STAGE(PG8_SA(0, 1), a2 + hstep, voffA);
            PG8_WAIT_L(8); PG8_BAR; PG8_WAIT_L(0); PG8_MMA(0, 0, At, B0); PG8_BAR; PG8_SCHED;
            PG8_LDB(B1, 1, 1); PG8_STAGE(PG8_SB(1, 0), b3, voffB);
            PG8_BAR; PG8_WAIT_L(0); PG8_MMA(0, 1, At, B1); PG8_BAR;
            PG8_LDA(At, 1, 1); PG8_STAGE(PG8_SA(1, 0), a3, voffA);
            PG8_BAR; PG8_WAIT_L(0); PG8_MMA(1, 0, At, B0); PG8_BAR; PG8_SCHED;
            PG8_STAGE(PG8_SB(1, 1), b3 + hstep, voffB);
            PG8_WAIT_V(6); PG8_BAR; PG8_MMA(1, 1, At, B1); PG8_BAR;
            }
        }
        if constexpr (ALIGN_EPI) { if (wr == 0) PG8_BAR; }
        if constexpr (!Epi::AFTER_DRAIN) { E(acc, cur, wr, wc, fr, fq); S.done(cur); }
        if (!has_next) break;
#pragma unroll
        for (int a = 0; a < 2; ++a)
#pragma unroll
            for (int b = 0; b < 2; ++b)
#pragma unroll
                for (int m = 0; m < 4; ++m)
#pragma unroll
                    for (int n = 0; n < 2; ++n) acc[a][b][m][n] = (f32x4){0.f, 0.f, 0.f, 0.f};
        cur = nxt; cA = nA; cB = nB; ++ui;
        if constexpr (ALIGN_EPI) { if (wr == 1) PG8_BAR; }
    }
    PG8_WAIT_V(0);
    if constexpr (!ALIGN_EPI) { if (wr == 0) PG8_BAR; }
    PG8_BAR;
    if constexpr (Epi::AFTER_DRAIN) { E.fused(acc, cur, wr, wc, fr, fq, lds, wid, lane); S.done(cur); }
#undef PG8_SA
#undef PG8_SB
#undef PG8_STAGE
#undef PG8_LDA
#undef PG8_LDB
#undef PG8_MMA
#undef PG8_WAIT_V
#undef PG8_WAIT_L
#undef PG8_BAR
#undef PG8_SCHED
}
}

#define LAS __attribute__((address_space(3)))
typedef unsigned short bf16;
typedef short bf16x8 __attribute__((ext_vector_type(8)));
typedef float f32x4 __attribute__((ext_vector_type(4)));
typedef float f32x2 __attribute__((ext_vector_type(2)));
typedef unsigned u32x2 __attribute__((ext_vector_type(2)));
typedef unsigned u32x4 __attribute__((ext_vector_type(4)));

constexpr int D = 1024, SEQ = 16384, NB = 16, TS = 16, MS = NB * TS, M = SEQ + MS, NBT = 17;
constexpr int DINE = 3584, DINO = 2048, DFF = 2816, DUP = 5632, MODW = 6144;
constexpr int NWAVES = 8, NTHR = 512;
constexpr int LDS_BYTES = 147456;

constexpr size_t O_Y = 0, O_YS = (size_t)SEQ * D, O_RETP = O_YS + (size_t)MS * D, O_RETS = O_RETP + 2 * 8 * 64 * 64,
    O_SCP = O_RETS + 2 * 16 * 8 * 64 * 64, O_SCS = O_SCP + 2 * 2 * 512, O_POOLP = O_SCS + 2 * 16 * 2 * 512, O_POOLS = O_POOLP + 2 * 15 * 512,
    O_KP = O_POOLS + 2 * 16 * 15 * 512, O_KS = O_KP + 2 * 512 * 512, O_VP = O_KS + 2 * 16 * 16 * 512, O_VS = O_VP + 2 * 512 * 512,
    O_FFNP = O_VS + 2 * 16 * 16 * 512, O_FFNS = O_FFNP + 4 * 2 * DUP, O_END = O_FFNS + 4 * 16 * 2 * DUP;
static_assert(O_END == 20788224, "d_out size");

constexpr size_t WS_CTL = 0, WS_WINE = 16384, WS_WOUTE = WS_WINE + (size_t)2 * DINE * D * 2, WS_WINO = WS_WOUTE + (size_t)2 * D * D * 2, WS_WOUTO = WS_WINO + (size_t)2 * DINO * D * 2,
    WS_WUP = WS_WOUTO + (size_t)2 * D * D * 2, WS_WDN = WS_WUP + (size_t)4 * DUP * D * 2, WS_POOLW = WS_WDN + (size_t)4 * D * DFF * 2, WS_MOD = WS_POOLW + (size_t)8 * 128 * 128 * 2,
    WS_ROPE = WS_MOD + (size_t)4 * NBT * MODW * 4, WS_HM = WS_ROPE + (size_t)(SEQ + 16) * 32 * 8, WS_MIX = WS_HM + (size_t)M * D * 2, WS_EXTRA = WS_MIX + (size_t)M * D * 2,
    WS_R1 = WS_HM + (size_t)M * DFF * 2, WS_KVS = WS_R1 + (size_t)M * DINE * 2, WS_END = WS_R1 + (size_t)M * DUP * 2;
static_assert(WS_KVS + (size_t)256 * 8 * 64 * 64 * 4 <= WS_END, "kvs fits");
static_assert(WS_HM % 256 == 0 && WS_R1 % 256 == 0 && WS_ROPE % 256 == 0 && WS_MOD % 256 == 0, "align");

struct Params { const float* in[27]; float* out; unsigned char* ws; };
enum { I_XP = 0, I_XS, I_SRET, I_SSCONV, I_SPOOL, I_CK, I_CV, I_SFFN, I_CP, I_CS, I_NMIX, I_NFFN, I_NFIN, I_WADA, I_BADA, I_WINE, I_WOUTE, I_GN, I_SCW,
       I_WINO, I_WOUTO, I_POOLW, I_POOLS, I_REL, I_WUP, I_FCONV, I_WDN };

__device__ __forceinline__ unsigned pk2(float lo, float hi) { return pg8::cvt_pk_bf16(lo, hi); }
__device__ __forceinline__ bf16 f2bf(float f) { return (bf16)(pk2(f, 0.f) & 0xffffu); }
__device__ __forceinline__ float bf2f(bf16 v) { return __uint_as_float(((unsigned)v) << 16); }
__device__ __forceinline__ float bflo(unsigned w) { return __uint_as_float(w << 16); }
__device__ __forceinline__ float bfhi(unsigned w) { return __uint_as_float(w & 0xffff0000u); }
template <int CTRL> __device__ __forceinline__ float dpp_f(float x) { return __builtin_bit_cast(float, __builtin_amdgcn_mov_dpp(__builtin_bit_cast(int, x), CTRL, 0xf, 0xf, true)); }
__device__ __forceinline__ float xrow16_max(float x) {
    auto s = __builtin_amdgcn_permlane16_swap(__float_as_uint(x), __float_as_uint(x), false, false);
    x = fmaxf(__uint_as_float(s[0]), __uint_as_float(s[1]));
    auto t = __builtin_amdgcn_permlane32_swap(__float_as_uint(x), __float_as_uint(x), false, false);
    return fmaxf(__uint_as_float(t[0]), __uint_as_float(t[1]));
}
__device__ __forceinline__ float xrow16_sum(float x) {
    auto s = __builtin_amdgcn_permlane16_swap(__float_as_uint(x), __float_as_uint(x), false, false);
    x = __uint_as_float(s[0]) + __uint_as_float(s[1]);
    auto t = __builtin_amdgcn_permlane32_swap(__float_as_uint(x), __float_as_uint(x), false, false);
    return __uint_as_float(t[0]) + __uint_as_float(t[1]);
}
__device__ __forceinline__ float wave_sum(float v) {
    v += dpp_f<0xB1>(v); v += dpp_f<0x4E>(v); v += dpp_f<0x124>(v); v += dpp_f<0x128>(v);
    return xrow16_sum(v);
}
__device__ __forceinline__ float silu_f(float a) { return a * __builtin_amdgcn_rcpf(1.0f + __builtin_amdgcn_exp2f(-1.4426950408889634f * a)); }
__device__ __forceinline__ float log2_gamma(int h) {
    return h < 4 ? (h < 2 ? (h == 0 ? -0.04580368961312479f : -0.02272007650008353f) : (h == 2 ? -0.011315313227834146f : -0.005646563141142063f))
                 : (h < 6 ? (h == 4 ? -0.0028205190623786626f : -0.0014095702546713536f) : (h == 6 ? -0.0007046129765893727f : -0.0003522634716290214f)); }
__device__ __forceinline__ float fexp2(float x) { return __builtin_amdgcn_exp2f(x); }
#define LDS_WAIT() asm volatile("s_waitcnt lgkmcnt(0)" ::: "memory")
__device__ __forceinline__ int fresh_tid() { int t; asm volatile("v_mov_b32 %0, %1" : "=v"(t) : "v"((int)threadIdx.x)); return t; }
#define PHASE_IDS const int tid = fresh_tid(), lane = tid & 63, wave = __builtin_amdgcn_readfirstlane(tid >> 6); const int gw = bx * NWAVES + wave, gtid = bx * NTHR + tid; (void)lane; (void)gw; (void)gtid;

template <int NT, int KS>
__device__ __forceinline__ void wave_mm(f32x4 (&acc)[NT], const LAS bf16* a, int lda, const LAS bf16* b, int ldb, int lane) {
    const int fr = lane & 15, fq = lane >> 4;
#pragma unroll
    for (int ks = 0; ks < KS; ++ks) {
        const bf16x8 af = *(const LAS bf16x8*)(a + fr * lda + ks * 32 + fq * 8);
#pragma unroll
        for (int nt = 0; nt < NT; ++nt) {
            const bf16x8 bfr = *(const LAS bf16x8*)(b + (nt * 16 + fr) * ldb + ks * 32 + fq * 8);
            acc[nt] = __builtin_amdgcn_mfma_f32_16x16x32_bf16(bfr, af, acc[nt], 0, 0, 0);
        }
    }
}

struct EpiBf {
    static constexpr bool PERM = true, AFTER_DRAIN = false;
    bf16* O; int ldc; int mode; int li; float* out;
    __device__ __forceinline__ void operator()(const f32x4 (&acc)[2][2][4][2], const pg8::Unit& u, int wr, int wc, int fr, int fq) const {
#pragma unroll
        for (int ai = 0; ai < 2; ++ai)
#pragma unroll
            for (int m = 0; m < 4; ++m) {
                const int r = u.pm * 256 + ai * 128 + wr * 64 + m * 16 + fr;
                bf16* rowp = O + (size_t)r * ldc;
#pragma unroll
                for (int bj = 0; bj < 2; ++bj) {
                    const int c = u.pn * 256 + bj * 128 + wc * 32 + 8 * fq;
                    const f32x4 v0 = acc[ai][bj][m][0], v1 = acc[ai][bj][m][1];
                    u32x4 w; w.x = pk2(v0[0], v0[1]); w.y = pk2(v0[2], v0[3]); w.z = pk2(v1[0], v1[1]); w.w = pk2(v1[2], v1[3]);
                    *(u32x4*)(rowp + c) = w;
                }
            }
        if (mode == 1 && u.pm >= 62 && (u.pn < 2 || u.pn >= 4)) {
#pragma unroll
            for (int ai = 0; ai < 2; ++ai)
#pragma unroll
                for (int m = 0; m < 4; ++m) {
                    const int r = u.pm * 256 + ai * 128 + wr * 64 + m * 16 + fr;
                    float* dst = nullptr;
                    if (u.pn < 2) {
                        if (r < SEQ) { if (r >= SEQ - 15) dst = out + O_POOLP + ((size_t)li * 15 + (r - (SEQ - 15))) * 512; }
                        else { const int b = (r - SEQ) >> 4, t = (r - SEQ) & 15; if (t >= 1) dst = out + O_POOLS + (((size_t)li * 16 + b) * 15 + (t - 1)) * 512; }
                        if (dst) dst += u.pn * 256;
                    } else {
                        const bool isv = u.pn >= 6;
                        if (r < SEQ) dst = out + (isv ? O_VP : O_KP) + ((size_t)li * 512 + (r - (SEQ - 512))) * 512;
                        else { const int b = (r - SEQ) >> 4, t = (r - SEQ) & 15; dst = out + (isv ? O_VS : O_KS) + (((size_t)li * 16 + b) * 16 + t) * 512; }
                        dst += (u.pn & 1) * 256;
                    }
                    if (dst) {
#pragma unroll
                        for (int bj = 0; bj < 2; ++bj)
#pragma unroll
                            for (int n = 0; n < 2; ++n) *(f32x4*)(dst + bj * 128 + wc * 32 + 8 * fq + 4 * n) = acc[ai][bj][m][n];
                    }
                }
        }
        if (mode == 2 && u.pm >= 63) {
#pragma unroll
            for (int ai = 0; ai < 2; ++ai)
#pragma unroll
                for (int m = 0; m < 4; ++m) {
                    const int r = u.pm * 256 + ai * 128 + wr * 64 + m * 16 + fr;
                    float* dst = nullptr;
                    if (r < SEQ) { if (r >= SEQ - 2) dst = out + O_FFNP + ((size_t)li * 2 + (r - (SEQ - 2))) * DUP; }
                    else { const int b = (r - SEQ) >> 4, t = (r - SEQ) & 15; if (t >= 14) dst = out + O_FFNS + (((size_t)li * 16 + b) * 2 + (t - 14)) * DUP; }
                    if (dst) {
                        dst += u.pn * 256;
#pragma unroll
                        for (int bj = 0; bj < 2; ++bj)
#pragma unroll
                            for (int n = 0; n < 2; ++n) *(f32x4*)(dst + bj * 128 + wc * 32 + 8 * fq + 4 * n) = acc[ai][bj][m][n];
                    }
                }
        }
    }
};
struct EpiRes {
    static constexpr bool PERM = false, AFTER_DRAIN = false;
    const float* base_p; const float* base_s; float* out; const float* gate;
    __device__ __forceinline__ void operator()(const f32x4 (&acc)[2][2][4][2], const pg8::Unit& u, int wr, int wc, int fr, int fq) const {
#pragma unroll
        for (int ai = 0; ai < 2; ++ai)
#pragma unroll
            for (int m = 0; m < 4; ++m) {
                const int r = u.pm * 256 + ai * 128 + wr * 64 + m * 16 + fr;
                const int b = r < SEQ ? 0 : 1 + ((r - SEQ) >> 4);
                const float* bp = r < SEQ ? base_p + (size_t)r * D : base_s + (size_t)(r - SEQ) * D;
                float* op = out + (size_t)r * D; const float* g = gate + b * MODW;
#pragma unroll
                for (int bj = 0; bj < 2; ++bj)
#pragma unroll
                    for (int n = 0; n < 2; ++n) {
                        const int c = u.pn * 256 + bj * 128 + wc * 32 + n * 16 + 4 * fq;
                        const f32x4 v = *(const f32x4*)(bp + c) + *(const f32x4*)(g + c) * acc[ai][bj][m][n];
                        *(f32x4*)(op + c) = v;
                    }
            }
    }
};


template <class F>
__device__ __forceinline__ void small_gemm(const bf16* A, const bf16* Bt, int N, int K, LAS unsigned char* lds, int bx, int G, int tid, int lane, int wave, F epi) {
    const int npieces = 16 * (N / 64), fr = lane & 15, fq = lane >> 4, kw = K / 8;
    LAS float* part = (LAS float*)lds;
    for (int p = bx; p < npieces; p += G) {
        const int xk = p >> 3, rg = xk & 15, cgi = (p & 7) * (N / 512) + (xk >> 4);
        const bf16* ap = A + (size_t)(rg * 16 + fr) * K + wave * kw + 8 * fq;
        const bf16* bp = Bt + (size_t)(cgi * 64 + fr) * K + wave * kw + 8 * fq;
        f32x4 acc[4];
#pragma unroll
        for (int i = 0; i < 4; ++i) acc[i] = (f32x4){0.f, 0.f, 0.f, 0.f};
#pragma unroll 4
        for (int ks = 0; ks < kw / 32; ++ks) {
            const bf16x8 af = *(const bf16x8*)(ap + ks * 32);
#pragma unroll
            for (int nt = 0; nt < 4; ++nt) { const bf16x8 bfr = *(const bf16x8*)(bp + (size_t)nt * 16 * K + ks * 32);
                acc[nt] = __builtin_amdgcn_mfma_f32_16x16x32_bf16(bfr, af, acc[nt], 0, 0, 0); }
        }
#pragma unroll
        for (int nt = 0; nt < 4; ++nt) *(LAS f32x4*)(part + wave * 1024 + fr * 64 + nt * 16 + 4 * fq) = acc[nt];
        __syncthreads();
        { const int r = tid >> 5, c2 = (tid & 31) * 2; float s0 = 0.f, s1 = 0.f;
#pragma unroll
          for (int w = 0; w < 8; ++w) { const f32x2 v = *(const LAS f32x2*)(part + w * 1024 + r * 64 + c2); s0 += v.x; s1 += v.y; }
          epi(rg * 16 + r, cgi * 64 + c2, s0, s1); }
        __syncthreads();
    }
}

__device__ __forceinline__ void p0_transpose_item(const float* W, int K, int N, bf16* WT, LAS float* scr, int item, int lane) {
    const int nblk = N / 32, kb = item / nblk, nb = item % nblk, k0 = 64 * kb, n0 = 32 * nb;
    float tv[32];
#pragma unroll
    for (int i = 0; i < 32; ++i) tv[i] = __builtin_nontemporal_load(W + (size_t)(k0 + 2 * i + (lane >> 5)) * N + n0 + (lane & 31));
#pragma unroll
    for (int i = 0; i < 32; ++i) scr[(2 * i + (lane >> 5)) * 33 + (lane & 31)] = tv[i];
    LDS_WAIT();
    const int c = lane & 7;
#pragma unroll
    for (int j = 0; j < 4; ++j) { const int n = (lane >> 3) + 8 * j; const LAS float* s = scr + (8 * c) * 33 + n;
        u32x4 o; o.x = pk2(s[0 * 33], s[1 * 33]); o.y = pk2(s[2 * 33], s[3 * 33]); o.z = pk2(s[4 * 33], s[5 * 33]); o.w = pk2(s[6 * 33], s[7 * 33]);
        *(u32x4*)(WT + (size_t)(n0 + n) * K + k0 + 8 * c) = o; }
    LDS_WAIT();
}
__device__ __forceinline__ void p0_transpose_mats(const float* W, int K, int N, bf16* WT, int nmat, LAS float* scr, int gw, int NGW, int lane) {
    const int per = (K / 64) * (N / 32), tot = per * nmat;
    for (int it = gw; it < tot; it += NGW) { const int mi = it / per, r = it % per;
        p0_transpose_item(W + (size_t)mi * K * N, K, N, WT + (size_t)mi * K * N, scr, r, lane); }
}
__device__ __forceinline__ void p0_mod_task(const Params& P, int task, LAS unsigned char* lds, int tid) {
    LAS float* CS = (LAS float*)lds;
    LAS float* RED = (LAS float*)(lds + NBT * D * 4);
    const int l = task / 48, e0 = (task % 48) * 128;
    { float cv[34];
#pragma unroll
      for (int j = 0; j < 34; ++j) { const int i = tid + j * NTHR; cv[j] = *(i < D ? P.in[I_CP] + i : P.in[I_CS] + (i - D)); }
#pragma unroll
      for (int j = 0; j < 34; ++j) CS[tid + j * NTHR] = silu_f(cv[j]); }
    __syncthreads();
    const int eq = tid & 31, dc = tid >> 5;
    f32x4 acc[NBT];
#pragma unroll
    for (int b = 0; b < NBT; ++b) acc[b] = (f32x4){0.f, 0.f, 0.f, 0.f};
    const float* wp = P.in[I_WADA] + ((size_t)l * D + dc * 64) * MODW + e0 + 4 * eq;
#pragma unroll 4
    for (int dd = 0; dd < 64; ++dd) {
        const f32x4 w = __builtin_nontemporal_load((const f32x4*)(wp + (size_t)dd * MODW));
#pragma unroll
        for (int b = 0; b < NBT; ++b) acc[b] += w * CS[b * D + dc * 64 + dd];
    }
    float* mod = (float*)(P.ws + WS_MOD);
#pragma unroll
    for (int b = 0; b < NBT; ++b) {
        *(LAS f32x4*)(RED + dc * 128 + 4 * eq) = acc[b];
        __syncthreads();
        if (tid < 128) { float s = P.in[I_BADA][l * MODW + e0 + tid];
#pragma unroll
            for (int k = 0; k < 16; ++k) s += RED[k * 128 + tid];
            mod[((size_t)l * NBT + b) * MODW + e0 + tid] = s; }
        __syncthreads();
    }
}
__device__ __forceinline__ void phase0(const Params& P, LAS unsigned char* lds, int tid, int lane, int wave) {
    const int G = gridDim.x, bx = blockIdx.x;
    for (int task = bx; task < 192; task += G) p0_mod_task(P, task, lds, tid);
    __syncthreads();
    LAS float* scr = (LAS float*)(lds + wave * 16384);
    const int gw = bx * NWAVES + wave, NGW = G * NWAVES;
    unsigned char* ws = P.ws;
    p0_transpose_mats(P.in[I_WUP], D, DUP, (bf16*)(ws + WS_WUP), 4, scr, gw, NGW, lane);
    p0_transpose_mats(P.in[I_WDN], DFF, D, (bf16*)(ws + WS_WDN), 4, scr, gw, NGW, lane);
    p0_transpose_mats(P.in[I_WINE], D, DINE, (bf16*)(ws + WS_WINE), 2, scr, gw, NGW, lane);
    p0_transpose_mats(P.in[I_WINO], D, DINO, (bf16*)(ws + WS_WINO), 2, scr, gw, NGW, lane);
    p0_transpose_mats(P.in[I_WOUTE], D, D, (bf16*)(ws + WS_WOUTE), 2, scr, gw, NGW, lane);
    p0_transpose_mats(P.in[I_WOUTO], D, D, (bf16*)(ws + WS_WOUTO), 2, scr, gw, NGW, lane);
    p0_transpose_mats(P.in[I_POOLW], 128, 128, (bf16*)(ws + WS_POOLW), 8, scr, gw, NGW, lane);
    f32x2* rope = (f32x2*)(ws + WS_ROPE);
    for (int i = bx * NTHR + tid; i < (SEQ + 16) * 32; i += G * NTHR) {
        const int pi = i >> 5, j = i & 31; const int pos = pi < SEQ ? pi : 4096 + (pi - SEQ);
        const float inv = exp2f(-(float)j * (13.287712379549449f / 32.0f));
        const float ang = (float)pos * inv;
        const double rev = (double)ang * 0.15915494309189535; const float fr = (float)(rev - floor(rev));
        rope[i] = (f32x2){__builtin_amdgcn_cosf(fr), __builtin_amdgcn_sinf(fr)};
    }
}

__device__ __forceinline__ void norm_phase(const float* xp, const float* xs, const float* nw, const float* mod, int sh_off, int sc_off, bf16* HM, int gw, int NGW, int lane) {
    f32x4 v0[4], v1[4], v2[4];
    auto rowp = [&](int m) { return (m < SEQ ? xp + (size_t)m * D : xs + (size_t)(m - SEQ) * D) + 8 * lane; };
    auto ld = [&](f32x4 (&v)[4], const float* xr) { v[0] = *(const f32x4*)xr; v[1] = *(const f32x4*)(xr + 4); v[2] = *(const f32x4*)(xr + 512); v[3] = *(const f32x4*)(xr + 516); };
    if (gw >= M) return;
    ld(v0, rowp(gw)); ld(v1, rowp(gw + NGW < M ? gw + NGW : gw));
    for (int m = gw; m < M; m += NGW) {
        const int m2 = m + 2 * NGW;
        ld(v2, rowp(m2 < M ? m2 : m));
        const int b = m < SEQ ? 0 : 1 + ((m - SEQ) >> 4);
        const float* md = mod + b * MODW + 8 * lane; const float* nwl = nw + 8 * lane;
        f32x4 g[4], sc[4], sh[4];
#pragma unroll
        for (int j = 0; j < 4; ++j) { const int off = (j >> 1) * 512 + (j & 1) * 4; g[j] = *(const f32x4*)(nwl + off); sc[j] = *(const f32x4*)(md + sc_off + off); sh[j] = *(const f32x4*)(md + sh_off + off); }
        float ss = 0.f;
#pragma unroll
        for (int j = 0; j < 4; ++j) ss += (v0[j].x * v0[j].x + v0[j].y * v0[j].y) + (v0[j].z * v0[j].z + v0[j].w * v0[j].w);
        const float rstd = 1.0f / sqrtf(wave_sum(ss) * (1.0f / D) + 1e-6f);
        f32x4 y[4];
#pragma unroll
        for (int j = 0; j < 4; ++j) y[j] = v0[j] * rstd * g[j] * (sc[j] + 1.0f) + sh[j];
        bf16* hr = HM + (size_t)m * D + 8 * lane;
        u32x4 w0, w1; w0.x = pk2(y[0].x, y[0].y); w0.y = pk2(y[0].z, y[0].w); w0.z = pk2(y[1].x, y[1].y); w0.w = pk2(y[1].z, y[1].w);
        w1.x = pk2(y[2].x, y[2].y); w1.y = pk2(y[2].z, y[2].w); w1.z = pk2(y[3].x, y[3].y); w1.w = pk2(y[3].z, y[3].w);
        *(u32x4*)hr = w0; *(u32x4*)(hr + 512) = w1;
#pragma unroll
        for (int j = 0; j < 4; ++j) { v0[j] = v1[j]; v1[j] = v2[j]; }
    }
}
__device__ __forceinline__ void final_norm_phase(float* x, const float* nw, int gw, int NGW, int lane) {
    for (int m = gw; m < M; m += NGW) {
        f32x4* xr = (f32x4*)(x + (size_t)m * D);
        f32x4 v[4]; float s = 0.f;
#pragma unroll
        for (int j = 0; j < 4; ++j) { v[j] = xr[lane + 64 * j]; s += (v[j].x * v[j].x + v[j].y * v[j].y) + (v[j].z * v[j].z + v[j].w * v[j].w); }
        const float rstd = 1.0f / sqrtf(wave_sum(s) * (1.0f / D) + 1e-6f);
#pragma unroll
        for (int j = 0; j < 4; ++j) { const f32x4 g = *(const f32x4*)(nw + 4 * (lane + 64 * j)); xr[lane + 64 * j] = v[j] * rstd * g; }
    }
}

constexpr int LP = 72;
__device__ __forceinline__ void kv_unit(const bf16* PROJ, const f32x2* rope, float* KVS, int n, int hp, LAS unsigned char* lds, int tid, int lane, int wave) {
    LAS bf16* base = (LAS bf16*)lds;
#pragma unroll
    for (int it = 0; it < 2; ++it) {
        const int item = tid + it * NTHR; const int jq = item & 7, hh = (item >> 3) & 1, c = item >> 4;
        const int h = hp * 2 + hh; const int row = n * 64 + c;
        const bf16* src = PROJ + (size_t)row * DINE + 512 + h * 64 + 4 * jq;
        const u32x2 a = *(const u32x2*)src, b2 = *(const u32x2*)(src + 32);
        const float x1[4] = {bflo(a.x), bfhi(a.x), bflo(a.y), bfhi(a.y)}, x2[4] = {bflo(b2.x), bfhi(b2.x), bflo(b2.y), bfhi(b2.y)};
        const float zs = fexp2(log2_gamma(h) * (float)(63 - c)) * 0.125f;
        LAS bf16* Kt = base + hh * (2 * 64 * LP);
#pragma unroll
        for (int r = 0; r < 4; ++r) { const f32x2 cs = rope[(size_t)row * 32 + 4 * jq + r];
            Kt[(4 * jq + r) * LP + c] = f2bf((x1[r] * cs.x - x2[r] * cs.y) * zs);
            Kt[(32 + 4 * jq + r) * LP + c] = f2bf((x1[r] * cs.y + x2[r] * cs.x) * zs); }
    }
#pragma unroll
    for (int it = 0; it < 2; ++it) {
        const int item = tid + it * NTHR; const int eo = item & 7, hh = (item >> 3) & 1, s = item >> 4;
        const int h = hp * 2 + hh; const int row = n * 64 + s;
        const u32x4 v = *(const u32x4*)(PROJ + (size_t)row * DINE + 1024 + h * 64 + 8 * eo);
        LAS bf16* Vt = base + hh * (2 * 64 * LP) + 64 * LP;
        const unsigned w[4] = {v.x, v.y, v.z, v.w};
#pragma unroll
        for (int k = 0; k < 4; ++k) { Vt[(8 * eo + 2 * k) * LP + s] = (bf16)(w[k] & 0xffffu); Vt[(8 * eo + 2 * k + 1) * LP + s] = (bf16)(w[k] >> 16); }
    }
    __syncthreads();
    {
        const int hh = wave >> 2, strip = wave & 3, h = hp * 2 + hh, fr = lane & 15, fq = lane >> 4;
        const LAS bf16* Kt = base + hh * (2 * 64 * LP); const LAS bf16* Vt = Kt + 64 * LP;
        f32x4 acc[4];
#pragma unroll
        for (int i = 0; i < 4; ++i) acc[i] = (f32x4){0.f, 0.f, 0.f, 0.f};
        wave_mm<4, 2>(acc, Kt + strip * 16 * LP, LP, Vt, LP, lane);
        float* dst = KVS + (((size_t)n * 8 + h) * 64 + strip * 16 + fr) * 64 + 4 * fq;
#pragma unroll
        for (int nt = 0; nt < 4; ++nt) *(f32x4*)(dst + nt * 16) = acc[nt];
    }
    __syncthreads();
}
__device__ __forceinline__ void sconv_items(const Params& P, int li, const bf16* PROJ, bf16* MIX, int gtid, int GT) {
    const float* cw = P.in[I_SCW] + (size_t)li * 3 * 512;
    const float* sbuf = P.in[I_SSCONV] + (size_t)li * 16 * 2 * 512;
    for (int item = gtid; item < M * 64; item += GT) {
        const int co = item & 63, m = item >> 6, c = 8 * co;
        const int t = m < SEQ ? m : (m - SEQ) & 15; const int b = m < SEQ ? 0 : (m - SEQ) >> 4;
        float u[3][8];
        u32x4 gcv[3], hvv[3];
#pragma unroll
        for (int k = 0; k < 3; ++k) {
            const bf16* rp = PROJ + (size_t)(t - 2 + k >= 0 ? m - 2 + k : m) * DINE;
            gcv[k] = *(const u32x4*)(rp + 2560 + c); hvv[k] = *(const u32x4*)(rp + 3072 + c);
        }
#pragma unroll
        for (int k = 0; k < 3; ++k) {
            const unsigned g4[4] = {gcv[k].x, gcv[k].y, gcv[k].z, gcv[k].w}, h4[4] = {hvv[k].x, hvv[k].y, hvv[k].z, hvv[k].w};
            const bool valid = t - 2 + k >= 0;
#pragma unroll
            for (int q = 0; q < 4; ++q) { u[k][2 * q] = valid ? bflo(g4[q]) * bflo(h4[q]) : 0.f; u[k][2 * q + 1] = valid ? bfhi(g4[q]) * bfhi(h4[q]) : 0.f; }
        }
        if (m >= SEQ && t < 2) {
#pragma unroll
            for (int k = 0; k < 2; ++k) if (t - 2 + k < 0) { const float* sp = sbuf + ((size_t)b * 2 + (t + k)) * 512 + c;
#pragma unroll
                for (int q = 0; q < 8; ++q) u[k][q] = sp[q]; }
        }
        const u32x4 gb = *(const u32x4*)(PROJ + (size_t)m * DINE + 2048 + c);
        const unsigned gb4[4] = {gb.x, gb.y, gb.z, gb.w};
        float y[8];
#pragma unroll
        for (int q = 0; q < 8; ++q) {
            const float conv = cw[c + q] * u[0][q] + cw[512 + c + q] * u[1][q] + cw[1024 + c + q] * u[2][q];
            const float g = (q & 1) ? bfhi(gb4[q >> 1]) : bflo(gb4[q >> 1]);
            y[q] = g * conv;
        }
        u32x4 o; o.x = pk2(y[0], y[1]); o.y = pk2(y[2], y[3]); o.z = pk2(y[4], y[5]); o.w = pk2(y[6], y[7]);
        *(u32x4*)(MIX + (size_t)m * D + 512 + c) = o;
        float* dst = nullptr;
        if (m < SEQ) { if (m >= SEQ - 2) dst = P.out + O_SCP + ((size_t)li * 2 + (m - (SEQ - 2))) * 512 + c; }
        else if (t >= 14) dst = P.out + O_SCS + (((size_t)li * 16 + b) * 2 + (t - 14)) * 512 + c;
        if (dst) {
#pragma unroll
            for (int q = 0; q < 8; ++q) dst[q] = u[2][q];
        }
    }
}
__device__ __forceinline__ void scan_task(float* KVS, float* retp, int w, LAS unsigned char* lds, int tid) {
    LAS float* TOT = (LAS float*)lds;
    const int e = tid & 127, seg = tid >> 7, el = w * 128 + e, h = el >> 12;
    const float l2g = log2_gamma(h), g64 = fexp2(l2g * 64.0f), g4096 = fexp2(l2g * 4096.0f);
    float* p = KVS + (size_t)(seg * 64) * 32768 + el;
    float v[64];
#pragma unroll
    for (int k = 0; k < 64; ++k) v[k] = p[(size_t)k * 32768];
    float tot = 0.f;
#pragma unroll
    for (int k = 0; k < 64; ++k) tot = tot * g64 + v[k];
    TOT[seg * 128 + e] = tot;
    __syncthreads();
    float R = 0.f;
    for (int s = 0; s < seg; ++s) R = R * g4096 + TOT[s * 128 + e];
#pragma unroll
    for (int k = 0; k < 64; ++k) { p[(size_t)k * 32768] = R; R = R * g64 + v[k]; }
    if (seg == 3) retp[el] = R;
    __syncthreads();
}
__device__ __forceinline__ void retout_unit(const Params& P, int li, const bf16* PROJ, const f32x2* rope, const float* KVS, bf16* MIX, int n, int hp,
                                            LAS unsigned char* lds, int tid, int lane, int wave) {
    constexpr int HB = 5 * 64 * LP;
    LAS bf16* base = (LAS bf16*)lds;
#pragma unroll
    for (int it = 0; it < 4; ++it) {
        const int item = tid + it * NTHR; const int jq = item & 7, qk = (item >> 3) & 1, hh = (item >> 4) & 1, c = item >> 5;
        const int h = hp * 2 + hh; const int row = n * 64 + c;
        const bf16* src = PROJ + (size_t)row * DINE + qk * 512 + h * 64 + 4 * jq;
        const u32x2 a = *(const u32x2*)src, b2 = *(const u32x2*)(src + 32);
        const float x1[4] = {bflo(a.x), bfhi(a.x), bflo(a.y), bfhi(a.y)}, x2[4] = {bflo(b2.x), bfhi(b2.x), bflo(b2.y), bfhi(b2.y)};
        const float sc = qk ? 0.125f : 1.0f;
        float o1[4], o2[4];
#pragma unroll
        for (int r = 0; r < 4; ++r) { const f32x2 cs = rope[(size_t)row * 32 + 4 * jq + r];
            o1[r] = (x1[r] * cs.x - x2[r] * cs.y) * sc; o2[r] = (x1[r] * cs.y + x2[r] * cs.x) * sc; }
        LAS bf16* dst = base + hh * HB + qk * (64 * LP) + c * LP + 4 * jq;
        u32x2 w1, w2; w1.x = pk2(o1[0], o1[1]); w1.y = pk2(o1[2], o1[3]); w2.x = pk2(o2[0], o2[1]); w2.y = pk2(o2[2], o2[3]);
        *(LAS u32x2*)dst = w1; *(LAS u32x2*)(dst + 32) = w2;
    }
#pragma unroll
    for (int it = 0; it < 2; ++it) {
        const int item = tid + it * NTHR; const int eo = item & 7, hh = (item >> 3) & 1, s = item >> 4;
        const int h = hp * 2 + hh; const int row = n * 64 + s;
        const u32x4 v = *(const u32x4*)(PROJ + (size_t)row * DINE + 1024 + h * 64 + 8 * eo);
        LAS bf16* Vt = base + hh * HB + 2 * 64 * LP;
        const unsigned w[4] = {v.x, v.y, v.z, v.w};
#pragma unroll
        for (int k = 0; k < 4; ++k) { Vt[(8 * eo + 2 * k) * LP + s] = (bf16)(w[k] & 0xffffu); Vt[(8 * eo + 2 * k + 1) * LP + s] = (bf16)(w[k] >> 16); }
    }
#pragma unroll
    for (int it = 0; it < 4; ++it) {
        const int item = tid + it * NTHR; const int eq = item & 15, hh = (item >> 4) & 1, d = item >> 5;
        const int h = hp * 2 + hh;
        const f32x4 v = *(const f32x4*)(KVS + (((size_t)n * 8 + h) * 64 + d) * 64 + 4 * eq);
        LAS bf16* Rt = base + hh * HB + 3 * 64 * LP;
#pragma unroll
        for (int k = 0; k < 4; ++k) Rt[(4 * eq + k) * LP + d] = f2bf(v[k]);
    }
    __syncthreads();
    {
        const int hh = wave >> 2, strip = wave & 3, h = hp * 2 + hh, fr = lane & 15, fq = lane >> 4;
        const LAS bf16* Qs = base + hh * HB + strip * 16 * LP; const LAS bf16* Ks = base + hh * HB + 64 * LP;
        const LAS bf16* Vt = base + hh * HB + 2 * 64 * LP; const LAS bf16* Rt = base + hh * HB + 3 * 64 * LP;
        LAS bf16* Pw = base + hh * HB + 4 * 64 * LP + strip * 16 * LP;
        const float l2g = log2_gamma(h);
        const int t = strip * 16 + fr;
        f32x4 S[4], O1[4], O2[4];
#pragma unroll
        for (int i = 0; i < 4; ++i) { S[i] = (f32x4){0.f, 0.f, 0.f, 0.f}; O1[i] = S[i]; O2[i] = S[i]; }
        wave_mm<4, 2>(S, Qs, LP, Ks, LP, lane);
#pragma unroll
        for (int nt = 0; nt < 4; ++nt) {
            float pv[4];
#pragma unroll
            for (int r = 0; r < 4; ++r) { const int dl = t - (nt * 16 + 4 * fq + r); pv[r] = dl >= 0 ? S[nt][r] * fexp2(l2g * (float)dl) : 0.f; }
            u32x2 w; w.x = pk2(pv[0], pv[1]); w.y = pk2(pv[2], pv[3]);
            *(LAS u32x2*)(Pw + fr * LP + nt * 16 + 4 * fq) = w;
        }
        LDS_WAIT();
        wave_mm<4, 2>(O1, Pw, LP, Vt, LP, lane);
        wave_mm<4, 2>(O2, Qs, LP, Rt, LP, lane);
        const float xi = fexp2(l2g * (float)(t + 1));
        float s = 0.f;
#pragma unroll
        for (int nt = 0; nt < 4; ++nt) { O1[nt] = O1[nt] + O2[nt] * xi; s += (O1[nt][0] + O1[nt][1]) + (O1[nt][2] + O1[nt][3]); }
        s = xrow16_sum(s);
        const float mean = s * (1.0f / 64.0f); float q = 0.f;
#pragma unroll
        for (int nt = 0; nt < 4; ++nt) { O1[nt] = O1[nt] - mean; q += (O1[nt][0] * O1[nt][0] + O1[nt][1] * O1[nt][1]) + (O1[nt][2] * O1[nt][2] + O1[nt][3] * O1[nt][3]); }
        q = xrow16_sum(q);
        const float rstd = 1.0f / sqrtf(q * (1.0f / 64.0f) + 1e-6f);
        const int row = n * 64 + t;
        const float* gain = P.in[I_GN] + (size_t)li * 512 + h * 64;
#pragma unroll
        for (int nt = 0; nt < 4; ++nt) { const int e = nt * 16 + 4 * fq;
            const u32x2 gg = *(const u32x2*)(PROJ + (size_t)row * DINE + 1536 + h * 64 + e);
            const f32x4 gn = *(const f32x4*)(gain + e);
            const float g0 = silu_f(bflo(gg.x)), g1 = silu_f(bfhi(gg.x)), g2 = silu_f(bflo(gg.y)), g3 = silu_f(bfhi(gg.y));
            u32x2 w; w.x = pk2(g0 * O1[nt][0] * rstd * gn[0], g1 * O1[nt][1] * rstd * gn[1]); w.y = pk2(g2 * O1[nt][2] * rstd * gn[2], g3 * O1[nt][3] * rstd * gn[3]);
            *(u32x2*)(MIX + (size_t)row * D + h * 64 + e) = w; }
    }
    __syncthreads();
}

__device__ __forceinline__ void kv_units_pipelined(const bf16* PROJ, const f32x2* rope, float* KVS, int bx, int G, LAS unsigned char* lds, int tid, int lane, int wave) {
    LAS bf16* base = (LAS bf16*)lds;
    u32x2 ka[2], kb[2]; f32x2 cs[2][4]; u32x4 vv[2];
    auto gload = [&](int u) { const int n = u >> 2, hp = u & 3;
#pragma unroll
        for (int it = 0; it < 2; ++it) { const int item = tid + it * NTHR;
            { const int jq = item & 7, hh = (item >> 3) & 1, c = item >> 4; const int row = n * 64 + c;
              const bf16* src = PROJ + (size_t)row * DINE + 512 + (hp * 2 + hh) * 64 + 4 * jq;
              ka[it] = *(const u32x2*)src; kb[it] = *(const u32x2*)(src + 32);
#pragma unroll
              for (int r = 0; r < 4; ++r) cs[it][r] = rope[(size_t)row * 32 + 4 * jq + r]; }
            { const int eo = item & 7, hh = (item >> 3) & 1, s = item >> 4;
              vv[it] = *(const u32x4*)(PROJ + (size_t)(n * 64 + s) * DINE + 1024 + (hp * 2 + hh) * 64 + 8 * eo); } } };
    auto lstore = [&](int u) { const int hp = u & 3;
#pragma unroll
        for (int it = 0; it < 2; ++it) { const int item = tid + it * NTHR;
            { const int jq = item & 7, hh = (item >> 3) & 1, c = item >> 4; const int h = hp * 2 + hh;
              const u32x2 a = ka[it], b2 = kb[it];
              const float x1[4] = {bflo(a.x), bfhi(a.x), bflo(a.y), bfhi(a.y)}, x2[4] = {bflo(b2.x), bfhi(b2.x), bflo(b2.y), bfhi(b2.y)};
              const float zs = fexp2(log2_gamma(h) * (float)(63 - c)) * 0.125f;
              LAS bf16* Kt = base + hh * (2 * 64 * LP);
#pragma unroll
              for (int r = 0; r < 4; ++r) { const f32x2 c2 = cs[it][r];
                  Kt[(4 * jq + r) * LP + c] = f2bf((x1[r] * c2.x - x2[r] * c2.y) * zs);
                  Kt[(32 + 4 * jq + r) * LP + c] = f2bf((x1[r] * c2.y + x2[r] * c2.x) * zs); } }
            { const int eo = item & 7, hh = (item >> 3) & 1, s = item >> 4;
              LAS bf16* Vt = base + hh * (2 * 64 * LP) + 64 * LP;
              const unsigned w[4] = {vv[it].x, vv[it].y, vv[it].z, vv[it].w};
#pragma unroll
              for (int k = 0; k < 4; ++k) { Vt[(8 * eo + 2 * k) * LP + s] = (bf16)(w[k] & 0xffffu); Vt[(8 * eo + 2 * k + 1) * LP + s] = (bf16)(w[k] >> 16); } } } };
    int u = bx; if (u >= 1024) return;
    gload(u);
    for (; u < 1024; u += G) {
        lstore(u);
        __syncthreads();
        if (u + G < 1024) gload(u + G);
        {
            const int n = u >> 2, hp = u & 3, hh = wave >> 2, strip = wave & 3, h = hp * 2 + hh, fr = lane & 15, fq = lane >> 4;
            const LAS bf16* Kt = base + hh * (2 * 64 * LP); const LAS bf16* Vt = Kt + 64 * LP;
            f32x4 acc[4];
#pragma unroll
            for (int i = 0; i < 4; ++i) acc[i] = (f32x4){0.f, 0.f, 0.f, 0.f};
            wave_mm<4, 2>(acc, Kt + strip * 16 * LP, LP, Vt, LP, lane);
            float* dst = KVS + (((size_t)n * 8 + h) * 64 + strip * 16 + fr) * 64 + 4 * fq;
#pragma unroll
            for (int nt = 0; nt < 4; ++nt) *(f32x4*)(dst + nt * 16) = acc[nt];
        }
        __syncthreads();
    }
}
__device__ __forceinline__ void retout_units_pipelined(const Params& P, int li, const bf16* PROJ, const f32x2* rope, const float* KVS, bf16* MIX, int bx, int G,
                                                       LAS unsigned char* lds, int tid, int lane, int wave) {
    constexpr int HB = 5 * 64 * LP;
    LAS bf16* base = (LAS bf16*)lds;
    u32x2 qa[4], qb[4]; f32x2 cs[4][4]; u32x4 vv[2]; f32x4 rr[4];
    auto gload = [&](int u) { const int n = u >> 2, hp = u & 3;
#pragma unroll
        for (int it = 0; it < 4; ++it) { const int item = tid + it * NTHR; const int jq = item & 7, qk = (item >> 3) & 1, hh = (item >> 4) & 1, c = item >> 5; const int row = n * 64 + c;
            const bf16* src = PROJ + (size_t)row * DINE + qk * 512 + (hp * 2 + hh) * 64 + 4 * jq;
            qa[it] = *(const u32x2*)src; qb[it] = *(const u32x2*)(src + 32);
#pragma unroll
            for (int r = 0; r < 4; ++r) cs[it][r] = rope[(size_t)row * 32 + 4 * jq + r];
            { const int eq = item & 15, h2 = (item >> 4) & 1, d = item >> 5;
              rr[it] = *(const f32x4*)(KVS + (((size_t)n * 8 + hp * 2 + h2) * 64 + d) * 64 + 4 * eq); } }
#pragma unroll
        for (int it = 0; it < 2; ++it) { const int item = tid + it * NTHR; const int eo = item & 7, hh = (item >> 3) & 1, s = item >> 4;
            vv[it] = *(const u32x4*)(PROJ + (size_t)(n * 64 + s) * DINE + 1024 + (hp * 2 + hh) * 64 + 8 * eo); } };
    auto lstore = [&]() {
#pragma unroll
        for (int it = 0; it < 4; ++it) { const int item = tid + it * NTHR; const int jq = item & 7, qk = (item >> 3) & 1, hh = (item >> 4) & 1, c = item >> 5;
            const u32x2 a = qa[it], b2 = qb[it];
            const float x1[4] = {bflo(a.x), bfhi(a.x), bflo(a.y), bfhi(a.y)}, x2[4] = {bflo(b2.x), bfhi(b2.x), bflo(b2.y), bfhi(b2.y)};
            const float sc = qk ? 0.125f : 1.0f;
            float o1[4], o2[4];
#pragma unroll
            for (int r = 0; r < 4; ++r) { const f32x2 c2 = cs[it][r]; o1[r] = (x1[r] * c2.x - x2[r] * c2.y) * sc; o2[r] = (x1[r] * c2.y + x2[r] * c2.x) * sc; }
            LAS bf16* dst = base + hh * HB + qk * (64 * LP) + c * LP + 4 * jq;
            u32x2 w1, w2; w1.x = pk2(o1[0], o1[1]); w1.y = pk2(o1[2], o1[3]); w2.x = pk2(o2[0], o2[1]); w2.y = pk2(o2[2], o2[3]);
            *(LAS u32x2*)dst = w1; *(LAS u32x2*)(dst + 32) = w2;
            { const int eq = item & 15, h2 = (item >> 4) & 1, d = item >> 5; LAS bf16* Rt = base + h2 * HB + 3 * 64 * LP;
#pragma unroll
              for (int k = 0; k < 4; ++k) Rt[(4 * eq + k) * LP + d] = f2bf(rr[it][k]); } }
#pragma unroll
        for (int it = 0; it < 2; ++it) { const int item = tid + it * NTHR; const int eo = item & 7, hh = (item >> 3) & 1, s = item >> 4;
            LAS bf16* Vt = base + hh * HB + 2 * 64 * LP; const unsigned w[4] = {vv[it].x, vv[it].y, vv[it].z, vv[it].w};
#pragma unroll
            for (int k = 0; k < 4; ++k) { Vt[(8 * eo + 2 * k) * LP + s] = (bf16)(w[k] & 0xffffu); Vt[(8 * eo + 2 * k + 1) * LP + s] = (bf16)(w[k] >> 16); } } };
    int u = bx; if (u >= 1024) return;
    gload(u);
    for (; u < 1024; u += G) {
        lstore();
        __syncthreads();
        if (u + G < 1024) gload(u + G);
        {
            const int n = u >> 2, hp = u & 3, hh = wave >> 2, strip = wave & 3, h = hp * 2 + hh, fr = lane & 15, fq = lane >> 4;
            const LAS bf16* Qs = base + hh * HB + strip * 16 * LP; const LAS bf16* Ks = base + hh * HB + 64 * LP;
            const LAS bf16* Vt = base + hh * HB + 2 * 64 * LP; const LAS bf16* Rt = base + hh * HB + 3 * 64 * LP;
            LAS bf16* Pw = base + hh * HB + 4 * 64 * LP + strip * 16 * LP;
            const float l2g = log2_gamma(h);
            const int t = strip * 16 + fr;
            f32x4 S[4], O1[4], O2[4];
#pragma unroll
            for (int i = 0; i < 4; ++i) { S[i] = (f32x4){0.f, 0.f, 0.f, 0.f}; O1[i] = S[i]; O2[i] = S[i]; }
            wave_mm<4, 2>(S, Qs, LP, Ks, LP, lane);
#pragma unroll
            for (int nt = 0; nt < 4; ++nt) {
                float pv[4];
#pragma unroll
                for (int r = 0; r < 4; ++r) { const int dl = t - (nt * 16 + 4 * fq + r); pv[r] = dl >= 0 ? S[nt][r] * fexp2(l2g * (float)dl) : 0.f; }
                u32x2 w; w.x = pk2(pv[0], pv[1]); w.y = pk2(pv[2], pv[3]);
                *(LAS u32x2*)(Pw + fr * LP + nt * 16 + 4 * fq) = w;
            }
            wave_mm<4, 2>(O1, Pw, LP, Vt, LP, lane);
            wave_mm<4, 2>(O2, Qs, LP, Rt, LP, lane);
            const float xi = fexp2(l2g * (float)(t + 1));
            float s = 0.f;
#pragma unroll
            for (int nt = 0; nt < 4; ++nt) { O1[nt] = O1[nt] + O2[nt] * xi; s += (O1[nt][0] + O1[nt][1]) + (O1[nt][2] + O1[nt][3]); }
            s = xrow16_sum(s);
            const float mean = s * (1.0f / 64.0f); float q = 0.f;
#pragma unroll
            for (int nt = 0; nt < 4; ++nt) { O1[nt] = O1[nt] - mean; q += (O1[nt][0] * O1[nt][0] + O1[nt][1] * O1[nt][1]) + (O1[nt][2] * O1[nt][2] + O1[nt][3] * O1[nt][3]); }
            q = xrow16_sum(q);
            const float rstd = 1.0f / sqrtf(q * (1.0f / 64.0f) + 1e-6f);
            const int row = n * 64 + t;
            const float* gain = P.in[I_GN] + (size_t)li * 512 + h * 64;
#pragma unroll
            for (int nt = 0; nt < 4; ++nt) { const int e = nt * 16 + 4 * fq;
                const u32x2 gg = *(const u32x2*)(PROJ + (size_t)row * DINE + 1536 + h * 64 + e);
                const f32x4 gn = *(const f32x4*)(gain + e);
                const float g0 = silu_f(bflo(gg.x)), g1 = silu_f(bfhi(gg.x)), g2 = silu_f(bflo(gg.y)), g3 = silu_f(bfhi(gg.y));
                u32x2 w; w.x = pk2(g0 * O1[nt][0] * rstd * gn[0], g1 * O1[nt][1] * rstd * gn[1]); w.y = pk2(g2 * O1[nt][2] * rstd * gn[2], g3 * O1[nt][3] * rstd * gn[3]);
                *(u32x2*)(MIX + (size_t)row * D + h * 64 + e) = w; }
        }
        __syncthreads();
    }
}

__device__ __forceinline__ void retstep_unit(const Params& P, int li, const bf16* PROJ, const f32x2* rope, bf16* MIX, int b, int h, LAS unsigned char* lds, int tid, int lane, int wave) {
    LAS float* q = (LAS float*)lds; LAS float* k = q + 1024; LAS float* v = k + 1024; LAS float* S = v + 1024; LAS float* sc = S + 4096;
    const float l2g = log2_gamma(h);
    const int row0 = SEQ + b * 16;
    { const int t = tid >> 5, j = tid & 31; const bf16* rp = PROJ + (size_t)(row0 + t) * DINE + h * 64;
      const f32x2 cs = rope[(size_t)(SEQ + t) * 32 + j];
      const float q1 = bf2f(rp[j]), q2 = bf2f(rp[32 + j]), k1 = bf2f(rp[512 + j]), k2 = bf2f(rp[512 + 32 + j]);
      q[t * 64 + j] = q1 * cs.x - q2 * cs.y; q[t * 64 + 32 + j] = q1 * cs.y + q2 * cs.x;
      k[t * 64 + j] = (k1 * cs.x - k2 * cs.y) * 0.125f; k[t * 64 + 32 + j] = (k1 * cs.y + k2 * cs.x) * 0.125f;
      v[t * 64 + j] = bf2f(rp[1024 + j]); v[t * 64 + 32 + j] = bf2f(rp[1024 + 32 + j]); }
    const float* Sg = P.in[I_SRET] + (((size_t)li * 16 + b) * 8 + h) * 4096;
#pragma unroll
    for (int i = 0; i < 8; ++i) S[tid + i * NTHR] = Sg[tid + i * NTHR];
    __syncthreads();
    if (tid < 256) { const int t = tid >> 4, s = tid & 15; float a = 0.f;
        if (s <= t) { for (int d = 0; d < 64; ++d) a += q[t * 64 + d] * k[s * 64 + d]; a *= fexp2(l2g * (float)(t - s)); }
        sc[tid] = a; }
    __syncthreads();
    {
        const int t0 = wave, t1 = wave + 8, e = lane; float in0 = 0.f, in1 = 0.f, cr0 = 0.f, cr1 = 0.f;
#pragma unroll
        for (int s4 = 0; s4 < 4; ++s4) { const f32x4 sa = *(const LAS f32x4*)(sc + t0 * 16 + 4 * s4), sb = *(const LAS f32x4*)(sc + t1 * 16 + 4 * s4);
#pragma unroll
            for (int j = 0; j < 4; ++j) { const float vv = v[(4 * s4 + j) * 64 + e]; in0 += sa[j] * vv; in1 += sb[j] * vv; } }
#pragma unroll 4
        for (int d4 = 0; d4 < 16; ++d4) { const f32x4 qa = *(const LAS f32x4*)(q + t0 * 64 + 4 * d4), qb = *(const LAS f32x4*)(q + t1 * 64 + 4 * d4);
#pragma unroll
            for (int j = 0; j < 4; ++j) { const float sv = S[(4 * d4 + j) * 64 + e]; cr0 += qa[j] * sv; cr1 += qb[j] * sv; } }
#pragma unroll
        for (int tt = 0; tt < 2; ++tt) {
            const int t = tt ? t1 : t0;
            float o = (tt ? in1 : in0) + (tt ? cr1 : cr0) * fexp2(l2g * (float)(t + 1));
            const float mean = wave_sum(o) * (1.0f / 64.0f); o -= mean;
            const float rstd = 1.0f / sqrtf(wave_sum(o * o) * (1.0f / 64.0f) + 1e-6f);
            const float g = bf2f(PROJ[(size_t)(row0 + t) * DINE + 1536 + h * 64 + e]);
            MIX[(size_t)(row0 + t) * D + h * 64 + e] = f2bf(silu_f(g) * o * rstd * P.in[I_GN][li * 512 + h * 64 + e]);
        }
    }
    float* Sn = P.out + O_RETS + (((size_t)li * 16 + b) * 8 + h) * 4096;
    const float g16 = fexp2(l2g * 16.0f);
    {
        const int e = tid & 63, d0 = tid >> 6; float a[8];
#pragma unroll
        for (int i = 0; i < 8; ++i) a[i] = S[tid + i * NTHR] * g16;
#pragma unroll 4
        for (int t = 0; t < 16; ++t) { const float vz = v[t * 64 + e] * fexp2(l2g * (float)(15 - t));
#pragma unroll
            for (int i = 0; i < 8; ++i) a[i] += k[t * 64 + d0 + 8 * i] * vz; }
#pragma unroll
        for (int i = 0; i < 8; ++i) Sn[tid + i * NTHR] = a[i];
    }
    __syncthreads();
}

__device__ __forceinline__ void attn_block(f32x4 (&O)[4], float& mrun, float& lrun, const LAS bf16* Qw, const LAS bf16* Kb, const LAS bf16* Vtb, LAS bf16* Pw,
                                           const LAS float* bias, int iq, int jbase, int nvalid, int lane) {
    const int fr = lane & 15, fq = lane >> 4;
    f32x4 S[4];
#pragma unroll
    for (int i = 0; i < 4; ++i) S[i] = (f32x4){0.f, 0.f, 0.f, 0.f};
    wave_mm<4, 2>(S, Qw, LP, Kb, LP, lane);
    float mx = -1e30f;
#pragma unroll
    for (int nt = 0; nt < 4; ++nt)
#pragma unroll
        for (int r = 0; r < 4; ++r) { const int j = nt * 16 + 4 * fq + r; int rel = 512 + iq - (jbase + j); rel = rel < -63 ? -63 : (rel > 256 ? 256 : rel);
            float s = S[nt][r] * 0.125f + bias[rel + 63]; if (j >= nvalid) s = -1e30f; S[nt][r] = s; mx = fmaxf(mx, s); }
    mx = fmaxf(mx, __shfl_xor(mx, 16)); mx = fmaxf(mx, __shfl_xor(mx, 32));
    const float mnew = fmaxf(mrun, mx), alpha = __expf(mrun - mnew);
    float ps = 0.f;
#pragma unroll
    for (int nt = 0; nt < 4; ++nt) {
        float p[4];
#pragma unroll
        for (int r = 0; r < 4; ++r) { p[r] = __expf(S[nt][r] - mnew); ps += p[r]; }
        u32x2 w; w.x = pk2(p[0], p[1]); w.y = pk2(p[2], p[3]);
        *(LAS u32x2*)(Pw + fr * LP + nt * 16 + 4 * fq) = w;
        O[nt] = O[nt] * alpha;
    }
    ps += __shfl_xor(ps, 16); ps += __shfl_xor(ps, 32);
    lrun = lrun * alpha + ps; mrun = mnew;
    LDS_WAIT();
    wave_mm<4, 2>(O, Pw, LP, Vtb, LP, lane);
}
__device__ __forceinline__ void attn_prompt_unit(const Params& P, int li, const bf16* PROJ, bf16* MIX, int n, int hp, LAS unsigned char* lds, int tid, int lane, int wave) {
    constexpr int HB = 4 * 64 * LP;
    LAS bf16* base = (LAS bf16*)lds; LAS float* biasb = (LAS float*)(lds + 2 * HB * 2);
#pragma unroll
    for (int it = 0; it < 2; ++it) {
        const int item = tid + it * NTHR; const int eo = item & 7, hh = (item >> 3) & 1, c = item >> 4; const int h = hp * 2 + hh;
        *(LAS u32x4*)(base + hh * HB + c * LP + 8 * eo) = *(const u32x4*)(PROJ + (size_t)(n * 64 + c) * DINO + 512 + h * 64 + 8 * eo);
    }
    for (int i = tid; i < 640; i += NTHR) { const int hh = i / 320, k = i % 320; biasb[i] = P.in[I_REL][((size_t)li * 8 + hp * 2 + hh) * 320 + k]; }
    const int hh = wave >> 2, strip = wave & 3, h = hp * 2 + hh, fr = lane & 15, fq = lane >> 4;
    f32x4 O[4];
#pragma unroll
    for (int i = 0; i < 4; ++i) O[i] = (f32x4){0.f, 0.f, 0.f, 0.f};
    float mrun = -1e30f, lrun = 0.f;
    for (int kb = (n < 8 ? 8 - n : 0); kb <= 8; ++kb) {
        const int kc = n - 8 + kb;
        __syncthreads();
#pragma unroll
        for (int it = 0; it < 2; ++it) {
            const int item = tid + it * NTHR; const int eo = item & 7, h2 = (item >> 3) & 1, s = item >> 4; const int hd = hp * 2 + h2;
            const bf16* rp = PROJ + (size_t)(kc * 64 + s) * DINO + hd * 64 + 8 * eo;
            *(LAS u32x4*)(base + h2 * HB + 64 * LP + s * LP + 8 * eo) = *(const u32x4*)(rp + 1024);
            const u32x4 v = *(const u32x4*)(rp + 1536);
            LAS bf16* Vt = base + h2 * HB + 2 * 64 * LP;
            const unsigned w[4] = {v.x, v.y, v.z, v.w};
#pragma unroll
            for (int k = 0; k < 4; ++k) { Vt[(8 * eo + 2 * k) * LP + s] = (bf16)(w[k] & 0xffffu); Vt[(8 * eo + 2 * k + 1) * LP + s] = (bf16)(w[k] >> 16); }
        }
        __syncthreads();
        attn_block(O, mrun, lrun, base + hh * HB + strip * 16 * LP, base + hh * HB + 64 * LP, base + hh * HB + 2 * 64 * LP, base + hh * HB + 3 * 64 * LP + strip * 16 * LP,
                   biasb + hh * 320, strip * 16 + fr, kb * 64, 64, lane);
    }
    const float inv = 1.0f / lrun; const int row = n * 64 + strip * 16 + fr;
#pragma unroll
    for (int nt = 0; nt < 4; ++nt) { u32x2 w; w.x = pk2(O[nt][0] * inv, O[nt][1] * inv); w.y = pk2(O[nt][2] * inv, O[nt][3] * inv);
        *(u32x2*)(MIX + (size_t)row * D + 512 + h * 64 + nt * 16 + 4 * fq) = w; }
    __syncthreads();
}
__device__ __forceinline__ void attn_sample_unit(const Params& P, int li, const bf16* PROJ, bf16* MIX, int b, int hq, LAS unsigned char* lds, int tid, int lane, int wave) {
    constexpr int HB = (16 + 64 + 64 + 16) * LP;
    LAS bf16* base = (LAS bf16*)lds; LAS float* biasb = (LAS float*)(lds + 4 * HB * 2);
    const int row0 = SEQ + b * 16;
    { const int eo = tid & 7, h4 = (tid >> 3) & 3, t = tid >> 5;
      *(LAS u32x4*)(base + h4 * HB + t * LP + 8 * eo) = *(const u32x4*)(PROJ + (size_t)(row0 + t) * DINO + 512 + (hq * 4 + h4) * 64 + 8 * eo); }
    for (int i = tid; i < 1280; i += NTHR) { const int h4 = i / 320, k = i % 320; biasb[i] = P.in[I_REL][((size_t)li * 8 + hq * 4 + h4) * 320 + k]; }
    const int fr = lane & 15, fq = lane >> 4;
    f32x4 O[4];
#pragma unroll
    for (int i = 0; i < 4; ++i) O[i] = (f32x4){0.f, 0.f, 0.f, 0.f};
    float mrun = -1e30f, lrun = 0.f;
    const float* ck = P.in[I_CK] + ((size_t)li * 16 + b) * 512 * 512; const float* cv = P.in[I_CV] + ((size_t)li * 16 + b) * 512 * 512;
    for (int kb = 0; kb <= 8; ++kb) {
        __syncthreads();
#pragma unroll
        for (int it = 0; it < 4; ++it) {
            const int item = tid + it * NTHR; const int eo = item & 7, h4 = (item >> 3) & 3, s = item >> 5; const int hd = hq * 4 + h4;
            float kf[8], vf[8];
            if (kb < 8) {
                const float* kp = ck + (size_t)(kb * 64 + s) * 512 + hd * 64 + 8 * eo; const float* vp = cv + (size_t)(kb * 64 + s) * 512 + hd * 64 + 8 * eo;
                const f32x4 k0 = *(const f32x4*)kp, k1 = *(const f32x4*)(kp + 4), v0 = *(const f32x4*)vp, v1 = *(const f32x4*)(vp + 4);
#pragma unroll
                for (int q = 0; q < 4; ++q) { kf[q] = k0[q]; kf[4 + q] = k1[q]; vf[q] = v0[q]; vf[4 + q] = v1[q]; }
            } else if (s < 16) {
                const bf16* rp = PROJ + (size_t)(row0 + s) * DINO + hd * 64 + 8 * eo;
                const u32x4 kk = *(const u32x4*)(rp + 1024), vv = *(const u32x4*)(rp + 1536);
                const unsigned k4[4] = {kk.x, kk.y, kk.z, kk.w}, v4[4] = {vv.x, vv.y, vv.z, vv.w};
#pragma unroll
                for (int q = 0; q < 4; ++q) { kf[2 * q] = bflo(k4[q]); kf[2 * q + 1] = bfhi(k4[q]); vf[2 * q] = bflo(v4[q]); vf[2 * q + 1] = bfhi(v4[q]); }
            } else {
#pragma unroll
                for (int q = 0; q < 8; ++q) { kf[q] = 0.f; vf[q] = 0.f; }
            }
            u32x4 kw; kw.x = pk2(kf[0], kf[1]); kw.y = pk2(kf[2], kf[3]); kw.z = pk2(kf[4], kf[5]); kw.w = pk2(kf[6], kf[7]);
            *(LAS u32x4*)(base + h4 * HB + 16 * LP + s * LP + 8 * eo) = kw;
            LAS bf16* Vt = base + h4 * HB + (16 + 64) * LP;
#pragma unroll
            for (int q = 0; q < 8; ++q) Vt[(8 * eo + q) * LP + s] = f2bf(vf[q]);
        }
        __syncthreads();
        if (wave < 4)
            attn_block(O, mrun, lrun, base + wave * HB, base + wave * HB + 16 * LP, base + wave * HB + (16 + 64) * LP, base + wave * HB + (16 + 64 + 64) * LP,
                       biasb + wave * 320, fr, kb * 64, kb < 8 ? 64 : 16, lane);
    }
    if (wave < 4) {
        const float inv = 1.0f / lrun; const int row = row0 + fr, h = hq * 4 + wave;
#pragma unroll
        for (int nt = 0; nt < 4; ++nt) { u32x2 w; w.x = pk2(O[nt][0] * inv, O[nt][1] * inv); w.y = pk2(O[nt][2] * inv, O[nt][3] * inv);
            *(u32x2*)(MIX + (size_t)row * D + 512 + h * 64 + nt * 16 + 4 * fq) = w; }
    }
    __syncthreads();
}

__device__ __forceinline__ int vperm(int s) { return (s & 32) | ((s & 12) << 1) | ((s & 16) >> 2) | (s & 3); }
constexpr int EXTN = 640;
__device__ __forceinline__ void attn_block2(f32x4 (&O)[4], float& mrun, float& lrun, const bf16x8 (&qf)[2], const LAS bf16* Kb, const LAS bf16* Vtb, const LAS float* biasp, int nvalid, int lane) {
    const int fr = lane & 15, fq = lane >> 4;
    f32x4 S[4];
#pragma unroll
    for (int i = 0; i < 4; ++i) S[i] = (f32x4){0.f, 0.f, 0.f, 0.f};
#pragma unroll
    for (int ks = 0; ks < 2; ++ks)
#pragma unroll
        for (int nt = 0; nt < 4; ++nt) { const bf16x8 kf = *(const LAS bf16x8*)(Kb + (nt * 16 + fr) * LP + ks * 32 + 8 * fq);
            S[nt] = __builtin_amdgcn_mfma_f32_16x16x32_bf16(kf, qf[ks], S[nt], 0, 0, 0); }
    float mx = -1e30f;
#pragma unroll
    for (int nt = 0; nt < 4; ++nt)
#pragma unroll
        for (int r = 0; r < 4; ++r) { float s = S[nt][r] * 0.18033688011112042f + biasp[51 - nt * 16 - r];
            if (nvalid < 64 && nt * 16 + 4 * fq + r >= nvalid) s = -1e30f;
            S[nt][r] = s; mx = fmaxf(mx, s); }
    mx = xrow16_max(mx);
    if (__builtin_amdgcn_ballot_w64(mx - mrun > 8.0f) != 0ull) {
        const float mnew = fmaxf(mrun, mx), alpha = __builtin_amdgcn_exp2f(mrun - mnew);
#pragma unroll
        for (int nt = 0; nt < 4; ++nt) O[nt] = O[nt] * alpha;
        lrun *= alpha; mrun = mnew;
    }
    float ps = 0.f;
#pragma unroll
    for (int nt = 0; nt < 4; ++nt)
#pragma unroll
        for (int r = 0; r < 4; ++r) { const float p = __builtin_amdgcn_exp2f(S[nt][r] - mrun); S[nt][r] = p; ps += p; }
    lrun += ps;
    bf16x8 pf[2];
#pragma unroll
    for (int ks = 0; ks < 2; ++ks) { u32x4 w; w.x = pk2(S[2 * ks][0], S[2 * ks][1]); w.y = pk2(S[2 * ks][2], S[2 * ks][3]); w.z = pk2(S[2 * ks + 1][0], S[2 * ks + 1][1]); w.w = pk2(S[2 * ks + 1][2], S[2 * ks + 1][3]);
        pf[ks] = __builtin_bit_cast(bf16x8, w); }
#pragma unroll
    for (int ks = 0; ks < 2; ++ks)
#pragma unroll
        for (int nt = 0; nt < 4; ++nt) { const bf16x8 vf = *(const LAS bf16x8*)(Vtb + (nt * 16 + fr) * LP + ks * 32 + 8 * fq);
            O[nt] = __builtin_amdgcn_mfma_f32_16x16x32_bf16(vf, pf[ks], O[nt], 0, 0, 0); }
}
__device__ __forceinline__ void attn_prompt_unit2(const Params& P, int li, const bf16* PROJ, bf16* MIX, int g, int hp, LAS unsigned char* lds, int tid, int lane, int wave) {
    constexpr int HBUF = 2 * 64 * LP;
    LAS bf16* base = (LAS bf16*)lds; LAS float* ext = (LAS float*)(lds + 4 * HBUF * 2);
    const int n0 = 4 * g, jstart = n0 < 8 ? 8 - n0 : 0;
    const int hh = wave >> 2, sw = wave & 3, h = hp * 2 + hh, fr = lane & 15, fq = lane >> 4;
    for (int i = tid; i < 2 * EXTN; i += NTHR) { const int h2 = i / EXTN, k = i % EXTN; ext[i] = P.in[I_REL][((size_t)li * 8 + hp * 2 + h2) * 320 + (k < 319 ? k : 319)] * 1.4426950408889634f; }
    bf16x8 qf[4][2];
#pragma unroll
    for (int qc = 0; qc < 4; ++qc)
#pragma unroll
        for (int ks = 0; ks < 2; ++ks) qf[qc][ks] = *(const bf16x8*)(PROJ + (size_t)((n0 + qc) * 64 + sw * 16 + fr) * DINO + 512 + h * 64 + ks * 32 + 8 * fq);
    u32x4 kreg[2], vreg[2];
    auto gload = [&](int j) {
        const int kc = n0 - 8 + j;
#pragma unroll
        for (int it = 0; it < 2; ++it) { const int item = tid + it * NTHR;
            { const int eo = item & 7, s = (item >> 3) & 63, h2 = item >> 9; kreg[it] = *(const u32x4*)(PROJ + (size_t)(kc * 64 + s) * DINO + 1024 + (hp * 2 + h2) * 64 + 8 * eo); }
            { const int s = item & 63, eo = (item >> 6) & 7, h2 = item >> 9; vreg[it] = *(const u32x4*)(PROJ + (size_t)(kc * 64 + s) * DINO + 1536 + (hp * 2 + h2) * 64 + 8 * eo); } } };
    auto lstore = [&](int buf) {
#pragma unroll
        for (int it = 0; it < 2; ++it) { const int item = tid + it * NTHR;
            { const int eo = item & 7, s = (item >> 3) & 63, h2 = item >> 9; *(LAS u32x4*)(base + (buf * 2 + h2) * HBUF + s * LP + 8 * eo) = kreg[it]; }
            { const int s = item & 63, eo = (item >> 6) & 7, h2 = item >> 9; LAS bf16* Vt = base + (buf * 2 + h2) * HBUF + 64 * LP + vperm(s);
              const unsigned w[4] = {vreg[it].x, vreg[it].y, vreg[it].z, vreg[it].w};
#pragma unroll
              for (int k = 0; k < 4; ++k) { Vt[(8 * eo + 2 * k) * LP] = (bf16)(w[k] & 0xffffu); Vt[(8 * eo + 2 * k + 1) * LP] = (bf16)(w[k] >> 16); } } } };
    f32x4 O[4][4]; float mrun[4], lrun[4];
#pragma unroll
    for (int qc = 0; qc < 4; ++qc) { mrun[qc] = -1e30f; lrun[qc] = 0.f;
#pragma unroll
        for (int i = 0; i < 4; ++i) O[qc][i] = (f32x4){0.f, 0.f, 0.f, 0.f}; }
    gload(jstart); lstore(jstart & 1);
    __syncthreads();
    for (int j = jstart; j <= 11; ++j) {
        if (j < 11) gload(j + 1);
        const LAS bf16* Kb = base + ((j & 1) * 2 + hh) * HBUF; const LAS bf16* Vtb = Kb + 64 * LP;
#pragma unroll
        for (int qc = 0; qc < 4; ++qc)
            if (qc <= j && j <= qc + 8)
                attn_block2(O[qc], mrun[qc], lrun[qc], qf[qc], Kb, Vtb, ext + hh * EXTN + (qc + 8 - j) * 64 + sw * 16 + 12 + fr - 4 * fq, 64, lane);
        if (j < 11) lstore((j + 1) & 1);
        __syncthreads();
    }
#pragma unroll
    for (int qc = 0; qc < 4; ++qc) { float lt = xrow16_sum(lrun[qc]); const float inv = __builtin_amdgcn_rcpf(lt); const int row = (n0 + qc) * 64 + sw * 16 + fr;
#pragma unroll
        for (int nt = 0; nt < 4; ++nt) { u32x2 w; w.x = pk2(O[qc][nt][0] * inv, O[qc][nt][1] * inv); w.y = pk2(O[qc][nt][2] * inv, O[qc][nt][3] * inv);
            *(u32x2*)(MIX + (size_t)row * D + 512 + h * 64 + nt * 16 + 4 * fq) = w; } }
}
__device__ __forceinline__ void attn_sample_unit2(const Params& P, int li, const bf16* PROJ, bf16* MIX, int b, int hq, LAS unsigned char* lds, int tid, int lane, int wave) {
    constexpr int HB = 2 * 64 * LP;
    LAS bf16* base = (LAS bf16*)lds; LAS float* ext = (LAS float*)(lds + 4 * HB * 2);
    const int row0 = SEQ + b * 16, fr = lane & 15, fq = lane >> 4;
    for (int i = tid; i < 4 * EXTN; i += NTHR) { const int h4 = i / EXTN, k = i % EXTN; ext[i] = P.in[I_REL][((size_t)li * 8 + hq * 4 + h4) * 320 + (k < 319 ? k : 319)] * 1.4426950408889634f; }
    bf16x8 qf[2];
#pragma unroll
    for (int ks = 0; ks < 2; ++ks) qf[ks] = *(const bf16x8*)(PROJ + (size_t)(row0 + fr) * DINO + 512 + (hq * 4 + (wave & 3)) * 64 + ks * 32 + 8 * fq);
    f32x4 O[4];
#pragma unroll
    for (int i = 0; i < 4; ++i) O[i] = (f32x4){0.f, 0.f, 0.f, 0.f};
    float mrun = -1e30f, lrun = 0.f;
    const float* ck = P.in[I_CK] + ((size_t)li * 16 + b) * 512 * 512; const float* cv = P.in[I_CV] + ((size_t)li * 16 + b) * 512 * 512;
    for (int kb = 0; kb <= 8; ++kb) {
        __syncthreads();
#pragma unroll
        for (int it = 0; it < 4; ++it) {
            const int item = tid + it * NTHR; const int eo = item & 7, h4 = (item >> 3) & 3, s = item >> 5; const int hd = hq * 4 + h4;
            float kf[8], vf[8];
            if (kb < 8) {
                const float* kp = ck + (size_t)(kb * 64 + s) * 512 + hd * 64 + 8 * eo; const float* vp = cv + (size_t)(kb * 64 + s) * 512 + hd * 64 + 8 * eo;
                const f32x4 k0 = *(const f32x4*)kp, k1 = *(const f32x4*)(kp + 4), v0 = *(const f32x4*)vp, v1 = *(const f32x4*)(vp + 4);
#pragma unroll
                for (int q = 0; q < 4; ++q) { kf[q] = k0[q]; kf[4 + q] = k1[q]; vf[q] = v0[q]; vf[4 + q] = v1[q]; }
            } else if (s < 16) {
                const bf16* rp = PROJ + (size_t)(row0 + s) * DINO + hd * 64 + 8 * eo;
                const u32x4 kk = *(const u32x4*)(rp + 1024), vv = *(const u32x4*)(rp + 1536);
                const unsigned k4[4] = {kk.x, kk.y, kk.z, kk.w}, v4[4] = {vv.x, vv.y, vv.z, vv.w};
#pragma unroll
                for (int q = 0; q < 4; ++q) { kf[2 * q] = bflo(k4[q]); kf[2 * q + 1] = bfhi(k4[q]); vf[2 * q] = bflo(v4[q]); vf[2 * q + 1] = bfhi(v4[q]); }
            } else {
#pragma unroll
                for (int q = 0; q < 8; ++q) { kf[q] = 0.f; vf[q] = 0.f; }
            }
            u32x4 kw; kw.x = pk2(kf[0], kf[1]); kw.y = pk2(kf[2], kf[3]); kw.z = pk2(kf[4], kf[5]); kw.w = pk2(kf[6], kf[7]);
            *(LAS u32x4*)(base + h4 * HB + s * LP + 8 * eo) = kw;
            LAS bf16* Vt = base + h4 * HB + 64 * LP + vperm(s);
#pragma unroll
            for (int q = 0; q < 8; ++q) Vt[(8 * eo + q) * LP] = f2bf(vf[q]);
        }
        __syncthreads();
        if (wave < 4)
            attn_block2(O, mrun, lrun, qf, base + wave * HB, base + wave * HB + 64 * LP, ext + wave * EXTN + 512 - kb * 64 + 12 + fr - 4 * fq, kb < 8 ? 64 : 16, lane);
    }
    if (wave < 4) {
        const float inv = 1.0f / lrun; const int row = row0 + fr, h = hq * 4 + wave;
#pragma unroll
        for (int nt = 0; nt < 4; ++nt) { u32x2 w; w.x = pk2(O[nt][0] * inv, O[nt][1] * inv); w.y = pk2(O[nt][2] * inv, O[nt][3] * inv);
            *(u32x2*)(MIX + (size_t)row * D + 512 + h * 64 + nt * 16 + 4 * fq) = w; }
    }
    __syncthreads();
}


__device__ __forceinline__ void attn_sample_unit3(const Params& P, int li, const bf16* PROJ, bf16* MIX, int b, int hp, LAS unsigned char* lds, int tid, int lane, int wave) {
    constexpr int HBUF = 2 * 64 * LP;
    LAS bf16* base = (LAS bf16*)lds; LAS float* ext = (LAS float*)(lds + 4 * HBUF * 2);
    const int row0 = SEQ + b * 16, fr = lane & 15, fq = lane >> 4;
    for (int i = tid; i < 2 * EXTN; i += NTHR) { const int h2 = i / EXTN, k = i % EXTN; ext[i] = P.in[I_REL][((size_t)li * 8 + hp * 2 + h2) * 320 + (k < 319 ? k : 319)] * 1.4426950408889634f; }
    bf16x8 qf[2];
#pragma unroll
    for (int ks = 0; ks < 2; ++ks) qf[ks] = *(const bf16x8*)(PROJ + (size_t)(row0 + fr) * DINO + 512 + (hp * 2 + (wave & 1)) * 64 + ks * 32 + 8 * fq);
    const float* ck = P.in[I_CK] + ((size_t)li * 16 + b) * 512 * 512; const float* cv = P.in[I_CV] + ((size_t)li * 16 + b) * 512 * 512;
    f32x4 kr[4], vr[4];
    auto gload = [&](int kb) {
#pragma unroll
        for (int it = 0; it < 2; ++it) { const int item = tid + it * NTHR;
            { const int eo = item & 7, s = (item >> 3) & 63, h2 = item >> 9; const int col = (hp * 2 + h2) * 64 + 8 * eo;
              if (kb < 8) { const float* p = ck + (size_t)(kb * 64 + s) * 512 + col; kr[2 * it] = *(const f32x4*)p; kr[2 * it + 1] = *(const f32x4*)(p + 4); }
              else if (s < 16) { const u32x4 w = *(const u32x4*)(PROJ + (size_t)(row0 + s) * DINO + 1024 + col);
                  kr[2 * it] = (f32x4){bflo(w.x), bfhi(w.x), bflo(w.y), bfhi(w.y)}; kr[2 * it + 1] = (f32x4){bflo(w.z), bfhi(w.z), bflo(w.w), bfhi(w.w)}; }
              else { kr[2 * it] = (f32x4){0.f, 0.f, 0.f, 0.f}; kr[2 * it + 1] = kr[2 * it]; } }
            { const int s = item & 63, eo = (item >> 6) & 7, h2 = item >> 9; const int col = (hp * 2 + h2) * 64 + 8 * eo;
              if (kb < 8) { const float* p = cv + (size_t)(kb * 64 + s) * 512 + col; vr[2 * it] = *(const f32x4*)p; vr[2 * it + 1] = *(const f32x4*)(p + 4); }
              else if (s < 16) { const u32x4 w = *(const u32x4*)(PROJ + (size_t)(row0 + s) * DINO + 1536 + col);
                  vr[2 * it] = (f32x4){bflo(w.x), bfhi(w.x), bflo(w.y), bfhi(w.y)}; vr[2 * it + 1] = (f32x4){bflo(w.z), bfhi(w.z), bflo(w.w), bfhi(w.w)}; }
              else { vr[2 * it] = (f32x4){0.f, 0.f, 0.f, 0.f}; vr[2 * it + 1] = vr[2 * it]; } } } };
    auto lstore = [&](int buf) {
#pragma unroll
        for (int it = 0; it < 2; ++it) { const int item = tid + it * NTHR;
            { const int eo = item & 7, s = (item >> 3) & 63, h2 = item >> 9; const f32x4 a = kr[2 * it], c = kr[2 * it + 1];
              u32x4 w; w.x = pk2(a[0], a[1]); w.y = pk2(a[2], a[3]); w.z = pk2(c[0], c[1]); w.w = pk2(c[2], c[3]);
              *(LAS u32x4*)(base + (buf * 2 + h2) * HBUF + s * LP + 8 * eo) = w; }
            { const int s = item & 63, eo = (item >> 6) & 7, h2 = item >> 9; LAS bf16* Vt = base + (buf * 2 + h2) * HBUF + 64 * LP + vperm(s);
              const f32x4 a = vr[2 * it], c = vr[2 * it + 1];
#pragma unroll
              for (int q = 0; q < 4; ++q) { Vt[(8 * eo + q) * LP] = f2bf(a[q]); Vt[(8 * eo + 4 + q) * LP] = f2bf(c[q]); } } } };
    f32x4 O[4];
#pragma unroll
    for (int i = 0; i < 4; ++i) O[i] = (f32x4){0.f, 0.f, 0.f, 0.f};
    float mrun = -1e30f, lrun = 0.f;
    gload(0); lstore(0);
    __syncthreads();
    for (int kb = 0; kb <= 8; ++kb) {
        if (kb < 8) gload(kb + 1);
        if (wave < 2) {
            const LAS bf16* Kb = base + ((kb & 1) * 2 + wave) * HBUF;
            attn_block2(O, mrun, lrun, qf, Kb, Kb + 64 * LP, ext + wave * EXTN + 512 - kb * 64 + 12 + fr - 4 * fq, kb < 8 ? 64 : 16, lane);
        }
        if (kb < 8) lstore((kb + 1) & 1);
        __syncthreads();
    }
    if (wave < 2) {
        float lt = xrow16_sum(lrun); const float inv = __builtin_amdgcn_rcpf(lt); const int row = row0 + fr, h = hp * 2 + wave;
#pragma unroll
        for (int nt = 0; nt < 4; ++nt) { u32x2 w; w.x = pk2(O[nt][0] * inv, O[nt][1] * inv); w.y = pk2(O[nt][2] * inv, O[nt][3] * inv);
            *(u32x2*)(MIX + (size_t)row * D + 512 + h * 64 + nt * 16 + 4 * fq) = w; }
    }
}

__device__ __forceinline__ void pool_unit(const Params& P, int li, const bf16* PROJ, const bf16* PWt, bf16* MIX, int rt, int g, LAS unsigned char* lds, int tid, int lane, int wave) {
    constexpr int PP = 136;
    LAS bf16* A = (LAS bf16*)lds; LAS bf16* Bt = A + 64 * PP;
    const bf16* pw = PWt + ((size_t)li * 4 + g) * 128 * 128;
#pragma unroll
    for (int it = 0; it < 4; ++it) { const int item = tid + it * NTHR; const int co = item & 15, d = item >> 4;
        *(LAS u32x4*)(Bt + d * PP + 8 * co) = *(const u32x4*)(pw + d * 128 + 8 * co); }
    {
        const int c = tid & 127, rq = tid >> 7;
        const int m0 = rt * 64 + rq * 16;
        const bool samp = m0 >= SEQ; const int b = samp ? (m0 - SEQ) >> 4 : 0;
        const int t0 = samp ? 0 : m0;
        const bf16* colp = PROJ + (size_t)m0 * DINO + g * 128 + c;
        const float* sp = P.in[I_SPOOL] + ((size_t)li * 16 + b) * 15 * 512 + g * 128 + c;
        float xv[31];
#pragma unroll
        for (int i = 15; i < 31; ++i) xv[i] = bf2f(colp[(ptrdiff_t)(i - 15) * DINO]);
        if (samp) {
#pragma unroll
            for (int i = 0; i < 15; ++i) xv[i] = sp[(size_t)i * 512];
        } else {
#pragma unroll
            for (int i = 0; i < 15; ++i) { const int tl = t0 - 15 + i; const float v = bf2f(colp[(ptrdiff_t)((tl >= 0 ? tl : 0) - t0) * DINO]); xv[i] = tl >= 0 ? v : 0.f; }
        }
        const int w = 2 << g;
        float ps[32]; ps[0] = 0.f;
#pragma unroll
        for (int j = 0; j < 31; ++j) ps[j + 1] = ps[j] + xv[j];
        float ws[16];
        if (g == 0) {
#pragma unroll
            for (int k = 0; k < 16; ++k) ws[k] = ps[16 + k] - ps[14 + k];
        } else if (g == 1) {
#pragma unroll
            for (int k = 0; k < 16; ++k) ws[k] = ps[16 + k] - ps[12 + k];
        } else if (g == 2) {
#pragma unroll
            for (int k = 0; k < 16; ++k) ws[k] = ps[16 + k] - ps[8 + k];
        } else {
#pragma unroll
            for (int k = 0; k < 16; ++k) ws[k] = ps[16 + k] - ps[k];
        }
#pragma unroll
        for (int k = 0; k < 16; ++k) {
            const int tl = t0 + k;
            const float cnt = samp ? (float)w : (float)(tl + 1 < w ? tl + 1 : w);
            A[(rq * 16 + k) * PP + c] = f2bf(ws[k] * __builtin_amdgcn_rcpf(cnt) - xv[15 + k]);
        }
    }
    __syncthreads();
    {
        const int strip = wave & 3, ch = wave >> 2, fr = lane & 15, fq = lane >> 4;
        f32x4 acc[4];
#pragma unroll
        for (int i = 0; i < 4; ++i) acc[i] = (f32x4){0.f, 0.f, 0.f, 0.f};
        wave_mm<4, 4>(acc, A + strip * 16 * PP, PP, Bt + ch * 64 * PP, PP, lane);
        const int row = rt * 64 + strip * 16 + fr;
        const float* ps = P.in[I_POOLS] + (size_t)li * 512 + g * 128 + ch * 64;
#pragma unroll
        for (int nt = 0; nt < 4; ++nt) { const f32x4 sc = *(const f32x4*)(ps + nt * 16 + 4 * fq);
            u32x2 w; w.x = pk2(acc[nt][0] * sc[0], acc[nt][1] * sc[1]); w.y = pk2(acc[nt][2] * sc[2], acc[nt][3] * sc[3]);
            *(u32x2*)(MIX + (size_t)row * D + g * 128 + ch * 64 + nt * 16 + 4 * fq) = w; }
    }
    __syncthreads();
}

__device__ __forceinline__ void convgate_items(const Params& P, int l, const bf16* UP, bf16* ACT, int gtid, int GT) {
    const float* cw = P.in[I_FCONV] + (size_t)l * 3 * DUP;
    constexpr int NCO = DFF / 8, NRB = M / 8;
    for (int item = gtid; item < NRB * NCO; item += GT) {
        const int co = item % NCO, rb = item / NCO, c = 8 * co, m0 = rb * 8;
        const bool samp = m0 >= SEQ; const int b = samp ? (m0 - SEQ) >> 4 : 0; const int t0 = samp ? (m0 - SEQ) & 15 : m0;
        float wa[3][8], wb[3][8];
#pragma unroll
        for (int j = 0; j < 3; ++j)
#pragma unroll
            for (int q = 0; q < 8; ++q) { wa[j][q] = cw[j * DUP + c + q]; wb[j][q] = cw[j * DUP + DFF + c + q]; }
        float ua[3][8], ub[3][8];
        u32x4 ra[10], rbv[10];
#pragma unroll
        for (int k = 0; k < 10; ++k) {
            const bf16* rp = UP + (size_t)((k < 2 && t0 == 0) ? m0 : m0 - 2 + k) * DUP + c;
            ra[k] = *(const u32x4*)rp; rbv[k] = *(const u32x4*)(rp + DFF);
        }
#pragma unroll
        for (int k = 0; k < 2; ++k) {
            const unsigned a4[4] = {ra[k].x, ra[k].y, ra[k].z, ra[k].w}, b4[4] = {rbv[k].x, rbv[k].y, rbv[k].z, rbv[k].w};
#pragma unroll
            for (int q = 0; q < 4; ++q) { ua[k][2 * q] = t0 > 0 ? bflo(a4[q]) : 0.f; ua[k][2 * q + 1] = t0 > 0 ? bfhi(a4[q]) : 0.f; ub[k][2 * q] = t0 > 0 ? bflo(b4[q]) : 0.f; ub[k][2 * q + 1] = t0 > 0 ? bfhi(b4[q]) : 0.f; }
        }
        if (samp && t0 == 0) {
#pragma unroll
            for (int k = 0; k < 2; ++k) { const float* sp = P.in[I_SFFN] + (((size_t)l * 16 + b) * 2 + k) * DUP + c;
#pragma unroll
                for (int q = 0; q < 8; ++q) { ua[k][q] = sp[q]; ub[k][q] = sp[DFF + q]; } }
        }
#pragma unroll
        for (int r = 0; r < 8; ++r) {
            const unsigned a4[4] = {ra[r + 2].x, ra[r + 2].y, ra[r + 2].z, ra[r + 2].w}, b4[4] = {rbv[r + 2].x, rbv[r + 2].y, rbv[r + 2].z, rbv[r + 2].w};
#pragma unroll
            for (int q = 0; q < 4; ++q) { ua[2][2 * q] = bflo(a4[q]); ua[2][2 * q + 1] = bfhi(a4[q]); ub[2][2 * q] = bflo(b4[q]); ub[2][2 * q + 1] = bfhi(b4[q]); }
            float y[8];
#pragma unroll
            for (int q = 0; q < 8; ++q) {
                const float av = wa[0][q] * ua[0][q] + wa[1][q] * ua[1][q] + wa[2][q] * ua[2][q];
                const float bv = wb[0][q] * ub[0][q] + wb[1][q] * ub[1][q] + wb[2][q] * ub[2][q];
                y[q] = silu_f(av) * bv;
                ua[0][q] = ua[1][q]; ua[1][q] = ua[2][q]; ub[0][q] = ub[1][q]; ub[1][q] = ub[2][q];
            }
            u32x4 o; o.x = pk2(y[0], y[1]); o.y = pk2(y[2], y[3]); o.z = pk2(y[4], y[5]); o.w = pk2(y[6], y[7]);
            *(u32x4*)(ACT + (size_t)(m0 + r) * DFF + c) = o;
        }
    }
}


#define XB_TMO      128
#define XB_XCNT(j)  (256  + 64 * (j))
#define XB_XSUB(j)  (1280 + 64 * (j))
#define XB_XGEN(j)  (2304 + 64 * (j))
#define XB_TOP      3328
#define XB_TOPGEN   3392
#define XCD_BAR_WORDS 3456
#define XB_SPIN_CAP (1u << 18)

__device__ __forceinline__ unsigned xb_ld(unsigned* p)              { return __hip_atomic_load(p, __ATOMIC_RELAXED, __HIP_MEMORY_SCOPE_AGENT); }
__device__ __forceinline__ unsigned xb_add(unsigned* p, unsigned v) { return __hip_atomic_fetch_add(p, v, __ATOMIC_RELAXED, __HIP_MEMORY_SCOPE_AGENT); }
__device__ __forceinline__ unsigned xb_xcc_id() { return (unsigned)__builtin_amdgcn_s_getreg((3 << 11) | 20) & 0xFu; }
#define XB_SPIN(cond, bar) do { unsigned _sp = 0; while (cond) { __builtin_amdgcn_s_sleep(1); \
    if ((++_sp & 255u) == 0u) { if (xb_ld(&(bar)[XB_TMO])) break; if (_sp > XB_SPIN_CAP) { atomicAdd(&(bar)[XB_TMO], 1u); break; } } } } while (0)

struct XcdBarrier {
    unsigned* bar; unsigned x;
    volatile LAS unsigned* st;
};

__device__ __forceinline__ XcdBarrier xcd_barrier_post(unsigned* bar, volatile LAS unsigned* st) {
    XcdBarrier b; b.bar = bar; b.x = xb_xcc_id(); b.st = st;
    if (threadIdx.x == 0) (void)xb_add(&bar[XB_XCNT(b.x)], 1u);
    return b;
}
__device__ __forceinline__ void xcd_barrier_complete(unsigned* bar, unsigned x, unsigned& nloc, unsigned& nx) {
    const unsigned G = gridDim.x * gridDim.y * gridDim.z;
    unsigned sum, cnt, mine, sp = 0u;
    for (;;) {
        sum = 0u; cnt = 0u; mine = 0u;
#pragma unroll
        for (unsigned j = 0; j < 16; ++j) { const unsigned c = xb_ld(&bar[XB_XCNT(j)]); sum += c; cnt += (c > 0u) ? 1u : 0u; mine = (j == x) ? c : mine; }
        if (sum == G) break;
        __builtin_amdgcn_s_sleep(1);
        if ((++sp & 255u) == 0u) { if (xb_ld(&bar[XB_TMO])) break; if (sp > XB_SPIN_CAP) { atomicAdd(&bar[XB_TMO], 1u); break; } }
    }
    nloc = mine > 0u ? mine : 1u; nx = cnt > 0u ? cnt : 1u;
}

__device__ __forceinline__ void xcd_barrier(const XcdBarrier& b) {
    asm volatile("s_waitcnt vmcnt(0)" ::: "memory");
    __syncthreads();
    if (threadIdx.x == 0) {
        unsigned* bar = b.bar;
        __builtin_amdgcn_s_waitcnt(0);
        unsigned nloc = b.st[0], nx = b.st[1];
        if (nloc == 0u) { xcd_barrier_complete(bar, b.x, nloc, nx); b.st[0] = nloc; b.st[1] = nx; }
        const unsigned old = xb_add(&bar[XB_XSUB(b.x)], 1u);
        const unsigned gen = old / nloc;
        if (old + 1u == (gen + 1u) * nloc) {
            __builtin_amdgcn_fence(__ATOMIC_RELEASE, "agent");
            asm volatile("s_waitcnt vmcnt(0)" ::: "memory");
            const unsigned og = xb_add(&bar[XB_TOP], 1u);
            const unsigned tg = og / nx;
            if (og + 1u == (tg + 1u) * nx) xb_add(&bar[XB_TOPGEN], 1u);
            else XB_SPIN(xb_ld(&bar[XB_TOPGEN]) == tg, bar);
            __builtin_amdgcn_fence(__ATOMIC_ACQUIRE, "agent");
            xb_add(&bar[XB_XGEN(b.x)], 1u);
            asm volatile("s_waitcnt vmcnt(0)" ::: "memory");
        } else {
            XB_SPIN(xb_ld(&bar[XB_XGEN(b.x)]) == gen, bar);
            __builtin_amdgcn_fence(__ATOMIC_ACQUIRE, "agent");
            asm volatile("s_waitcnt vmcnt(0)" ::: "memory");
        }
    }
    __syncthreads();
}
__global__ void __launch_bounds__(NTHR) mega_fwd(Params P) {
    extern __shared__ __attribute__((aligned(16))) unsigned char lds_raw[];
    cg::grid_group grid = cg::this_grid();
    LAS unsigned char* lds = (LAS unsigned char*)lds_raw;
    const int G = gridDim.x, bx = blockIdx.x;
    const int NGW = G * NWAVES, GT = G * NTHR;
    unsigned char* ws = P.ws;
    bf16* HM = (bf16*)(ws + WS_HM); bf16* MIX = (bf16*)(ws + WS_MIX); bf16* ACT = (bf16*)(ws + WS_HM);
    bf16* R1 = (bf16*)(ws + WS_R1); float* KVS = (float*)(ws + WS_KVS);
    float* MOD = (float*)(ws + WS_MOD); const f32x2* rope = (const f32x2*)(ws + WS_ROPE);
    float* X = P.out;
    volatile LAS unsigned* MISC = (volatile LAS unsigned*)(lds + 131072 + 512);
    unsigned* barw = (unsigned*)(ws + WS_CTL);
    if (threadIdx.x < 2) MISC[threadIdx.x] = 0u;
    if (bx == 0) for (int i = threadIdx.x; i < XCD_BAR_WORDS; i += NTHR) barw[i] = 0u;
    __syncthreads();

    { PHASE_IDS phase0(P, lds, tid, lane, wave); }
    grid.sync();
    const XcdBarrier xbar = xcd_barrier_post(barw, MISC);

    for (int l = 0; l < 4; ++l) {
        const int li = l >> 1; const bool even = (l & 1) == 0;
        const float* modl = MOD + (size_t)l * NBT * MODW;
        for (int half = 0; half < 2; ++half) {
            const bool first = (l == 0 && half == 0);
            const float* xp = first ? P.in[I_XP] : X; const float* xs = first ? P.in[I_XS] : X + (size_t)SEQ * D;
            { PHASE_IDS norm_phase(xp, xs, (half == 0 ? P.in[I_NMIX] : P.in[I_NFFN]) + (size_t)l * D, modl, half * 3072, half * 3072 + 1024, HM, gw, NGW, lane); }
            xcd_barrier(xbar);
            {
                const int N = half == 1 ? DUP : (even ? DINE : DINO);
                const bf16* Wt = half == 1 ? (const bf16*)(ws + WS_WUP) + (size_t)l * DUP * D
                                           : (even ? (const bf16*)(ws + WS_WINE) + (size_t)li * DINE * D : (const bf16*)(ws + WS_WINO) + (size_t)li * DINO * D);
                const bool split = (half == 0 && !even);
                const int Mg = split ? SEQ : M;
                pg8::Gemm g{HM, Wt, Mg, N, D}; pg8::StaticOrder S; S.init(Mg, N, G, bx);
                EpiBf E{R1, N, half == 1 ? 2 : (even ? 0 : 1), half == 1 ? l : li, P.out};
                pg8::gemm_phase<EpiBf, pg8::StaticOrder, true, true>(lds, g, S, E);
                if (split) { PHASE_IDS
                    float* outp = P.out; bf16* PR = R1;
                    small_gemm(HM + (size_t)SEQ * D, Wt, DINO, D, lds, bx, G, tid, lane, wave, [=](int sr, int c, float s0, float s1) {
                        const int b = sr >> 4, t = sr & 15;
                        *(unsigned*)(PR + (size_t)(SEQ + sr) * DINO + c) = pk2(s0, s1);
                        float* dst = nullptr;
                        if (c < 512) { if (t >= 1) dst = outp + O_POOLS + (((size_t)li * 16 + b) * 15 + (t - 1)) * 512 + c; }
                        else if (c >= 1536) dst = outp + O_VS + (((size_t)li * 16 + b) * 16 + t) * 512 + (c - 1536);
                        else if (c >= 1024) dst = outp + O_KS + (((size_t)li * 16 + b) * 16 + t) * 512 + (c - 1024);
                        if (dst) *(f32x2*)dst = (f32x2){s0, s1};
                    });
                }
            }
            xcd_barrier(xbar);
            if (half == 0) {
                if (even) {
                    { PHASE_IDS
                    kv_units_pipelined(R1, rope, KVS, bx, G, lds, tid, lane, wave);
                    sconv_items(P, li, R1, MIX, gtid, GT); }
                    xcd_barrier(xbar);
                    { PHASE_IDS for (int w = bx; w < 256; w += G) scan_task(KVS, P.out + O_RETP + (size_t)li * 32768, w, lds, tid); }
                    xcd_barrier(xbar);
                    { PHASE_IDS
                    retout_units_pipelined(P, li, R1, rope, KVS, MIX, bx, G, lds, tid, lane, wave);
                    for (int u = bx + ((1024 - bx + G - 1) / G) * G; u < 1024 + 128; u += G) retstep_unit(P, li, R1, rope, MIX, (u - 1024) >> 3, (u - 1024) & 7, lds, tid, lane, wave);
                    }
                } else {
                    { PHASE_IDS
                    const int nsplit = G > 128 ? 64 : 0;
                    if (bx < nsplit || nsplit == 0) for (int u = bx; u < 64; u += (nsplit ? nsplit : G)) attn_sample_unit3(P, li, R1, MIX, u >> 2, u & 3, lds, tid, lane, wave);
                    if (bx >= nsplit) for (int u = bx - nsplit; u < 1040; u += G - nsplit) pool_unit(P, li, R1, (const bf16*)(ws + WS_POOLW), MIX, u >> 2, u & 3, lds, tid, lane, wave);
                    for (int u = bx; u < 256; u += G) attn_prompt_unit2(P, li, R1, MIX, u >> 2, u & 3, lds, tid, lane, wave);
                    }
                }
            } else {
                { PHASE_IDS convgate_items(P, l, R1, ACT, gtid, GT); }
            }
            xcd_barrier(xbar);
            {
                const int K = half == 1 ? DFF : D;
                const bf16* A = half == 1 ? ACT : MIX;
                const bf16* Wt = half == 1 ? (const bf16*)(ws + WS_WDN) + (size_t)l * D * DFF
                                           : (even ? (const bf16*)(ws + WS_WOUTE) + (size_t)li * D * D : (const bf16*)(ws + WS_WOUTO) + (size_t)li * D * D);
                pg8::Gemm g{A, Wt, SEQ, D, K}; pg8::StaticOrder S; S.init(SEQ, D, G, bx);
                EpiRes E{xp, xs, X, modl + half * 3072 + 2048};
                pg8::gemm_phase<EpiRes, pg8::StaticOrder, true, true>(lds, g, S, E);
                { PHASE_IDS
                    const float* gate = modl + half * 3072 + 2048; float* Xs = X + (size_t)SEQ * D;
                    small_gemm(A + (size_t)SEQ * K, Wt, D, K, lds, bx, G, tid, lane, wave, [=](int sr, int c, float s0, float s1) {
                        const float* g2 = gate + (1 + (sr >> 4)) * MODW + c; const float* bp = xs + (size_t)sr * D + c;
                        *(f32x2*)(Xs + (size_t)sr * D + c) = (f32x2){bp[0] + g2[0] * s0, bp[1] + g2[1] * s1};
                    });
                }
            }
            xcd_barrier(xbar);
        }
    }
    { PHASE_IDS final_norm_phase(X, P.in[I_NFIN], gw, NGW, lane); }
}

extern "C" void kernel_launch(void* const* d_in, const int* in_sizes, int n_in, void* d_out, int out_size, void* d_ws, size_t ws_size, hipStream_t stream) {
    static int grid = 0;
    if (grid == 0) {
        if (n_in != 27 || (size_t)out_size != O_END || ws_size < WS_END) { fprintf(stderr, "kernel_launch: unexpected shapes: n_in %d out %d ws %zu (need %zu)\n", n_in, out_size, ws_size, (size_t)WS_END); grid = -1; return; }
        int dev = 0, cus = 0, per_cu = 0;
        hipGetDevice(&dev); hipDeviceGetAttribute(&cus, hipDeviceAttributeMultiprocessorCount, dev);
        hipFuncSetAttribute((const void*)mega_fwd, hipFuncAttributeMaxDynamicSharedMemorySize, LDS_BYTES);
        hipOccupancyMaxActiveBlocksPerMultiprocessor(&per_cu, (const void*)mega_fwd, NTHR, LDS_BYTES);
        if (per_cu < 1) per_cu = 1;
        grid = cus;
        (void)hipGetLastError();
    }
    if (grid < 0) return;
    Params p{};
    for (int i = 0; i < 27; ++i) p.in[i] = (const float*)d_in[i];
    p.out = (float*)d_out; p.ws = (unsigned char*)d_ws;
    void* args[] = {&p};
    hipError_t e = hipLaunchCooperativeKernel((const void*)mega_fwd, dim3(grid), dim3(NTHR), args, LDS_BYTES, stream);
    if (e != hipSuccess) fprintf(stderr, "cooperative launch failed: %s (grid %d)\n", hipGetErrorString(e), grid);
}
```

```cpp
#include <hip/hip_runtime.h>
#include <hip/hip_cooperative_groups.h>
#include <cstdio>
#include <cstdint>
namespace cg = cooperative_groups;
namespace pg8 {
#define PG8_LAS __attribute__((address_space(3)))
typedef unsigned short bf16_t;
typedef short bf16x8 __attribute__((ext_vector_type(8)));
typedef float f32x4 __attribute__((ext_vector_type(4)));
typedef unsigned u32x4 __attribute__((ext_vector_type(4)));
constexpr int BM = 256, BK = 64, HALF = 128, HTB = HALF * BK * 2  , STAGE_BYTES = 8 * HTB, NXCD = 8, WGM = 4;

__host__ __device__ __forceinline__ int lds_byte(int r, int c) { const int st = (r >> 4) * 2 + (c >> 5), rr = r & 15, cc = c & 31, ob = rr * 64 + cc * 2; return st * 1024 + (ob ^ (((ob >> 9) & 1) << 5)); }
__host__ __device__ __forceinline__ void stage_rc(int b, int& R, int& C) { const int st = b / 1024, sb = b % 1024, swz = sb ^ (((sb >> 9) & 1) << 5); R = (st >> 1) * 16 + swz / 64; C = (st & 1) * 32 + (swz % 64) / 2; }
__host__ __device__ __forceinline__ int perm32(int rho) { const int n = rho >> 4, i = rho & 15; return 8 * (i >> 2) + 4 * n + (i & 3); }

struct Unit { int pm, pn; };
struct Gemm { const bf16_t* A; const bf16_t* Bt; int M, N, K; };

struct StaticOrder {
    int nM, nN, nwg, G, c;
    __host__ __device__ void init(int M, int N, int G_, int c_) { nM = M / BM; nN = N / BM; nwg = nM * nN; G = G_; c = c_; }
    __host__ __device__ bool next(int i, Unit& u) const {
        const long L = (long)i * G + c; if (L >= nwg) return false;
        int wgid = (int)L; { const int q = nwg / NXCD, r = nwg % NXCD, xcd = wgid % NXCD, off = wgid / NXCD; wgid = (xcd < r ? xcd * (q + 1) : r * (q + 1) + (xcd - r) * q) + off; }
        const int nig = WGM * nN, gid = wgid / nig, fm = gid * WGM, gsz = (nM - fm) < WGM ? (nM - fm) : WGM;
        u.pm = fm + ((wgid % nig) % gsz); u.pn = (wgid % nig) / gsz; return true;
    }
    __device__ __forceinline__ void a_ready(const Unit&) const {}
    __device__ __forceinline__ void done(const Unit&) const {}
};

__device__ __forceinline__ unsigned cvt_pk_bf16(float lo, float hi) { unsigned r; asm volatile("v_cvt_pk_bf16_f32 %0, %1, %2" : "=v"(r) : "v"(lo), "v"(hi)); return r; }
template <class Epi, class Sched, bool ALIGN_EPI = false, bool SP2 = false>
__device__ __forceinline__ void gemm_phase(PG8_LAS unsigned char* lds, const Gemm g, const Sched& S, const Epi& E) {
    int tid; asm volatile("v_mov_b32 %0, %1" : "=v"(tid) : "v"((int)threadIdx.x));
    const int wid = __builtin_amdgcn_readfirstlane(tid >> 6), lane = tid & 63, wr = wid >> 2, wc = wid & 3, fr = lane & 15, fq = lane >> 4;
    const int K = g.K, nt = K / BK;
    unsigned voffA[2], voffB[2];
#pragma unroll
    for (int i = 0; i < 2; ++i) { int R, C; stage_rc(tid * 16 + i * 8192, R, C); const int Rb = Epi::PERM ? ((R & ~31) + perm32(R & 31)) : R;
        voffA[i] = (unsigned)(R * K + C) * 2u; voffB[i] = (unsigned)(Rb * K + C) * 2u; }
    const size_t kstep = (size_t)(BK * 2);
    const size_t hstep = (size_t)HALF * K * 2;
    const size_t tstep = 2 * hstep;
    const unsigned ldsw = (unsigned)wid * 1024u;
    const int aoff = lds_byte(wr * 64 + fr, fq * 8), boff = lds_byte(wc * 32 + fr, fq * 8);
#define PG8_SA(b, h) (((b) * 2 + (h)) * HTB)
#define PG8_SB(b, h) ((4 + (b) * 2 + (h)) * HTB)
#define PG8_STAGE(bufoff, gbase, voff) do { _Pragma("unroll") for (int _i = 0; _i < 2; ++_i) \
        __builtin_amdgcn_global_load_lds((const unsigned*)((const char*)(gbase) + (voff)[_i]), (PG8_LAS unsigned*)(lds + (bufoff) + ldsw + _i * 8192), 16, 0, 0); } while (0)
#define PG8_LDA(dst, b, h) do { _Pragma("unroll") for (int m = 0; m < 4; ++m) _Pragma("unroll") for (int k = 0; k < 2; ++k) dst[m][k] = *(const PG8_LAS bf16x8*)(lds + PG8_SA(b, h) + aoff + m * 2048 + k * 1024); } while (0)
#define PG8_LDB(dst, b, h) do { _Pragma("unroll") for (int n = 0; n < 2; ++n) _Pragma("unroll") for (int k = 0; k < 2; ++k) dst[n][k] = *(const PG8_LAS bf16x8*)(lds + PG8_SB(b, h) + boff + n * 2048 + k * 1024); } while (0)
#define PG8_MMA(ai, bj, At, Bt) do { __builtin_amdgcn_s_setprio(1); _Pragma("unroll") for (int m = 0; m < 4; ++m) _Pragma("unroll") for (int n = 0; n < 2; ++n) _Pragma("unroll") for (int k = 0; k < 2; ++k) \
        acc[ai][bj][m][n] = __builtin_amdgcn_mfma_f32_16x16x32_bf16(Bt[n][k], At[m][k], acc[ai][bj][m][n], 0, 0, 0); __builtin_amdgcn_s_setprio(0); } while (0)
#define PG8_WAIT_V(n) asm volatile("s_waitcnt vmcnt(" #n ")" ::: "memory")
#define PG8_WAIT_L(n) asm volatile("s_waitcnt lgkmcnt(" #n ")" ::: "memory")
#define PG8_BAR __builtin_amdgcn_s_barrier()
#define PG8_SCHED __builtin_amdgcn_sched_barrier(0)
    Unit cur, nxt; int ui = 0;
    if (!S.next(0, cur)) return;
    f32x4 acc[2][2][4][2];
#pragma unroll
    for (int a = 0; a < 2; ++a)
#pragma unroll
        for (int b = 0; b < 2; ++b)
#pragma unroll
            for (int m = 0; m < 4; ++m)
#pragma unroll
                for (int n = 0; n < 2; ++n) acc[a][b][m][n] = (f32x4){0.f, 0.f, 0.f, 0.f};
    bf16x8 At[4][2], B0[2][2], B1[2][2];
    const char* cA = (const char*)g.A + (size_t)cur.pm * tstep; const char* cB = (const char*)g.Bt + (size_t)cur.pn * tstep;
    S.a_ready(cur);
    if constexpr (SP2) {
        PG8_STAGE(PG8_SB(0, 0), cB, voffB); PG8_STAGE(PG8_SB(0, 1), cB + hstep, voffB); PG8_STAGE(PG8_SA(0, 0), cA, voffA); PG8_STAGE(PG8_SA(0, 1), cA + hstep, voffA);
        if (wr == 1) PG8_BAR;
        PG8_WAIT_V(2); PG8_BAR;
        PG8_STAGE(PG8_SB(1, 0), cB + kstep, voffB); PG8_STAGE(PG8_SA(1, 0), cA + kstep, voffA); PG8_STAGE(PG8_SB(1, 1), cB + hstep + kstep, voffB);
        PG8_WAIT_V(6); PG8_BAR;
    } else {
        PG8_STAGE(PG8_SB(0, 0), cB, voffB); PG8_STAGE(PG8_SA(0, 0), cA, voffA); PG8_STAGE(PG8_SB(0, 1), cB + hstep, voffB); PG8_STAGE(PG8_SA(0, 1), cA + hstep, voffA);
        if (wr == 1) PG8_BAR;
        PG8_WAIT_V(4); PG8_BAR;
        PG8_STAGE(PG8_SB(1, 0), cB + kstep, voffB); PG8_STAGE(PG8_SA(1, 0), cA + kstep, voffA); PG8_STAGE(PG8_SB(1, 1), cB + hstep + kstep, voffB);
        PG8_WAIT_V(6); PG8_BAR;
    }
    for (;;) {
        const bool has_next = S.next(ui + 1, nxt);
        const char* nA = has_next ? (const char*)g.A + (size_t)nxt.pm * tstep : cA; const char* nB = has_next ? (const char*)g.Bt + (size_t)nxt.pn * tstep : cB;
        for (int t = 0; t < nt; t += 2) {
            const bool last = (t == nt - 2);
            const char* a1 = cA + (size_t)(t + 1) * kstep;
            const char* a2 = last ? nA : cA + (size_t)(t + 2) * kstep; const char* b2 = last ? nB : cB + (size_t)(t + 2) * kstep;
            const char* a3 = a2 + kstep; const char* b3 = b2 + kstep;
            if (last && has_next) S.a_ready(nxt);
            if constexpr (SP2) {
            PG8_LDB(B0, 0, 0); PG8_LDB(B1, 0, 1); PG8_SCHED; PG8_LDA(At, 0, 0); PG8_STAGE(PG8_SA(1, 1), a1 + hstep, voffA);
            PG8_WAIT_V(8); PG8_WAIT_L(0); PG8_BAR; PG8_MMA(0, 0, At, B0); PG8_MMA(0, 1, At, B1); PG8_BAR; PG8_SCHED;
            PG8_LDA(At, 0, 1); PG8_STAGE(PG8_SB(0, 0), b2, voffB); PG8_STAGE(PG8_SB(0, 1), b2 + hstep, voffB); PG8_STAGE(PG8_SA(0, 0), a2, voffA);
            PG8_WAIT_V(8); PG8_WAIT_L(0); PG8_BAR; PG8_MMA(1, 0, At, B0); PG8_MMA(1, 1, At, B1); PG8_BAR; PG8_SCHED;
            PG8_LDB(B0, 1, 0); PG8_LDB(B1, 1, 1); PG8_SCHED; PG8_LDA(At, 1, 0); PG8_STAGE(PG8_SA(0, 1), a2 + hstep, voffA);
            PG8_WAIT_V(8); PG8_WAIT_L(0); PG8_BAR; PG8_MMA(0, 0, At, B0); PG8_MMA(0, 1, At, B1); PG8_BAR; PG8_SCHED;
            PG8_LDA(At, 1, 1); PG8_STAGE(PG8_SB(1, 0), b3, voffB); PG8_STAGE(PG8_SB(1, 1), b3 + hstep, voffB); PG8_STAGE(PG8_SA(1, 0), a3, voffA);
            PG8_WAIT_V(8); PG8_WAIT_L(0); PG8_BAR; PG8_MMA(1, 0, At, B0); PG8_MMA(1, 1, At, B1); PG8_BAR; PG8_SCHED;
            } else {
            PG8_LDB(B0, 0, 0); PG8_SCHED; PG8_LDA(At, 0, 0); PG8_STAGE(PG8_SA(1, 1), a1 + hstep, voffA);
            PG8_WAIT_L(8); PG8_BAR; PG8_WAIT_L(0); PG8_MMA(0, 0, At, B0); PG8_BAR; PG8_SCHED;
            PG8_LDB(B1, 0, 1); PG8_STAGE(PG8_SB(0, 0), b2, voffB);
            PG8_BAR; PG8_WAIT_L(0); PG8_MMA(0, 1, At, B1); PG8_BAR;
            PG8_LDA(At, 0, 1); PG8_STAGE(PG8_SA(0, 0), a2, voffA);
            PG8_BAR; PG8_WAIT_L(0); PG8_MMA(1, 0, At, B0); PG8_BAR; PG8_SCHED;
            PG8_STAGE(PG8_SB(0, 1), b2 + hstep, voffB);
            PG8_WAIT_V(6); PG8_BAR; PG8_MMA(1, 1, At, B1); PG8_BAR;
            PG8_LDB(B0, 1, 0); PG8_SCHED; PG8_LDA(At, 1, 0); PG8_STAGE(PG8_SA(0, 1), a2 + hstep, voffA);
            PG8_WAIT_L(8); PG8_BAR; PG8_WAIT_L(0); PG8_MMA(0, 0, At, B0); PG8_BAR; PG8_SCHED;
            PG8_LDB(B1, 1, 1); PG8_STAGE(PG8_SB(1, 0), b3, voffB);
            PG8_BAR; PG8_WAIT_L(0); PG8_MMA(0, 1, At, B1); PG8_BAR;
            PG8_LDA(At, 1, 1); PG8_STAGE(PG8_SA(1, 0), a3, voffA);
            PG8_BAR; PG8_WAIT_L(0); PG8_MMA(1, 0, At, B0); PG8_BAR; PG8_SCHED;
            PG8_STAGE(PG8_SB(1, 1), b3 + hstep, voffB);
            PG8_WAIT_V(6); PG8_BAR; PG8_MMA(1, 1, At, B1); PG8_BAR;
            }
        }
        if constexpr (ALIGN_EPI) { if (wr == 0) PG8_BAR; }
        if constexpr (!Epi::AFTER_DRAIN) { E(acc, cur, wr, wc, fr, fq); S.done(cur); }
        if (!has_next) break;
#pragma unroll
        for (int a = 0; a < 2; ++a)
#pragma unroll
            for (int b = 0; b < 2; ++b)
#pragma unroll
                for (int m = 0; m < 4; ++m)
#pragma unroll
                    for (int n = 0; n < 2; ++n) acc[a][b][m][n] = (f32x4){0.f, 0.f, 0.f, 0.f};
        cur = nxt; cA = nA; cB = nB; ++ui;
        if constexpr (ALIGN_EPI) { if (wr == 1) PG8_BAR; }
    }
    PG8_WAIT_V(0);
    if constexpr (!ALIGN_EPI) { if (wr == 0) PG8_BAR; }
    PG8_BAR;
    if constexpr (Epi::AFTER_DRAIN) { E.fused(acc, cur, wr, wc, fr, fq, lds, wid, lane); S.done(cur); }
#undef PG8_SA
#undef PG8_SB
#undef PG8_STAGE
#undef PG8_LDA
#undef PG8_LDB
#undef PG8_MMA
#undef PG8_WAIT_V
#undef PG8_WAIT_L
#undef PG8_BAR
#undef PG8_SCHED
}
}

#define LAS __attribute__((address_space(3)))
typedef unsigned short bf16;
typedef short bf16x8 __attribute__((ext_vector_type(8)));
typedef float f32x4 __attribute__((ext_vector_type(4)));
typedef float f32x2 __attribute__((ext_vector_type(2)));
typedef unsigned u32x2 __attribute__((ext_vector_type(2)));
typedef unsigned u32x4 __attribute__((ext_vector_type(4)));

constexpr int D = 1024, SEQ = 16384, NB = 16, TS = 16, MS = NB * TS, M = SEQ + MS, NBT = 17;
constexpr int DINE = 3584, DINO = 2048, DFF = 2816, DUP = 5632, MODW = 6144;
constexpr int NWAVES = 8, NTHR = 512;
constexpr int LDS_BYTES = 147456;

constexpr size_t O_Y = 0, O_YS = (size_t)SEQ * D, O_RETP = O_YS + (size_t)MS * D, O_RETS = O_RETP + 2 * 8 * 64 * 64,
    O_SCP = O_RETS + 2 * 16 * 8 * 64 * 64, O_SCS = O_SCP + 2 * 2 * 512, O_POOLP = O_SCS + 2 * 16 * 2 * 512, O_POOLS = O_POOLP + 2 * 15 * 512,
    O_KP = O_POOLS + 2 * 16 * 15 * 512, O_KS = O_KP + 2 * 512 * 512, O_VP = O_KS + 2 * 16 * 16 * 512, O_VS = O_VP + 2 * 512 * 512,
    O_FFNP = O_VS + 2 * 16 * 16 * 512, O_FFNS = O_FFNP + 4 * 2 * DUP, O_END = O_FFNS + 4 * 16 * 2 * DUP;
static_assert(O_END == 20788224, "d_out size");

constexpr size_t WS_CTL = 0, WS_WINE = 16384, WS_WOUTE = WS_WINE + (size_t)2 * DINE * D * 2, WS_WINO = WS_WOUTE + (size_t)2 * D * D * 2, WS_WOUTO = WS_WINO + (size_t)2 * DINO * D * 2,
    WS_WUP = WS_WOUTO + (size_t)2 * D * D * 2, WS_WDN = WS_WUP + (size_t)4 * DUP * D * 2, WS_POOLW = WS_WDN + (size_t)4 * D * DFF * 2, WS_MOD = WS_POOLW + (size_t)8 * 128 * 128 * 2,
    WS_ROPE = WS_MOD + (size_t)4 * NBT * MODW * 4, WS_HM = WS_ROPE + (size_t)(SEQ + 16) * 32 * 8, WS_MIX = WS_HM + (size_t)M * D * 2, WS_EXTRA = WS_MIX + (size_t)M * D * 2,
    WS_R1 = WS_HM + (size_t)M * DFF * 2, WS_KVS = WS_R1 + (size_t)M * DINE * 2, WS_END = WS_R1 + (size_t)M * DUP * 2;
static_assert(WS_KVS + (size_t)256 * 8 * 64 * 64 * 4 <= WS_END, "kvs fits");
static_assert(WS_HM % 256 == 0 && WS_R1 % 256 == 0 && WS_ROPE % 256 == 0 && WS_MOD % 256 == 0, "align");

struct Params { const float* in[27]; float* out; unsigned char* ws; };
enum { I_XP = 0, I_XS, I_SRET, I_SSCONV, I_SPOOL, I_CK, I_CV, I_SFFN, I_CP, I_CS, I_NMIX, I_NFFN, I_NFIN, I_WADA, I_BADA, I_WINE, I_WOUTE, I_GN, I_SCW,
       I_WINO, I_WOUTO, I_POOLW, I_POOLS, I_REL, I_WUP, I_FCONV, I_WDN };

__device__ __forceinline__ unsigned pk2(float lo, float hi) { return pg8::cvt_pk_bf16(lo, hi); }
__device__ __forceinline__ bf16 f2bf(float f) { return (bf16)(pk2(f, 0.f) & 0xffffu); }
__device__ __forceinline__ float bf2f(bf16 v) { return __uint_as_float(((unsigned)v) << 16); }
__device__ __forceinline__ float bflo(unsigned w) { return __uint_as_float(w << 16); }
__device__ __forceinline__ float bfhi(unsigned w) { return __uint_as_float(w & 0xffff0000u); }
template <int CTRL> __device__ __forceinline__ float dpp_f(float x) { return __builtin_bit_cast(float, __builtin_amdgcn_mov_dpp(__builtin_bit_cast(int, x), CTRL, 0xf, 0xf, true)); }
__device__ __forceinline__ float xrow16_max(float x) {
    auto s = __builtin_amdgcn_permlane16_swap(__float_as_uint(x), __float_as_uint(x), false, false);
    x = fmaxf(__uint_as_float(s[0]), __uint_as_float(s[1]));
    auto t = __builtin_amdgcn_permlane32_swap(__float_as_uint(x), __float_as_uint(x), false, false);
    return fmaxf(__uint_as_float(t[0]), __uint_as_float(t[1]));
}
__device__ __forceinline__ float xrow16_sum(float x) {
    auto s = __builtin_amdgcn_permlane16_swap(__float_as_uint(x), __float_as_uint(x), false, false);
    x = __uint_as_float(s[0]) + __uint_as_float(s[1]);
    auto t = __builtin_amdgcn_permlane32_swap(__float_as_uint(x), __float_as_uint(x), false, false);
    return __uint_as_float(t[0]) + __uint_as_float(t[1]);
}
__device__ __forceinline__ float wave_sum(float v) {
    v += dpp_f<0xB1>(v); v += dpp_f<0x4E>(v); v += dpp_f<0x124>(v); v += dpp_f<0x128>(v);
    return xrow16_sum(v);
}
__device__ __forceinline__ float silu_f(float a) { return a * __builtin_amdgcn_rcpf(1.0f + __builtin_amdgcn_exp2f(-1.4426950408889634f * a)); }
__device__ __forceinline__ float log2_gamma(int h) {
    return h < 4 ? (h < 2 ? (h == 0 ? -0.04580368961312479f : -0.02272007650008353f) : (h == 2 ? -0.011315313227834146f : -0.005646563141142063f))
                 : (h < 6 ? (h == 4 ? -0.0028205190623786626f : -0.0014095702546713536f) : (h == 6 ? -0.0007046129765893727f : -0.0003522634716290214f)); }
__device__ __forceinline__ float fexp2(float x) { return __builtin_amdgcn_exp2f(x); }
#define LDS_WAIT() asm volatile("s_waitcnt lgkmcnt(0)" ::: "memory")
__device__ __forceinline__ int fresh_tid() { int t; asm volatile("v_mov_b32 %0, %1" : "=v"(t) : "v"((int)threadIdx.x)); return t; }
#define PHASE_IDS const int tid = fresh_tid(), lane = tid & 63, wave = __builtin_amdgcn_readfirstlane(tid >> 6); const int gw = bx * NWAVES + wave, gtid = bx * NTHR + tid; (void)lane; (void)gw; (void)gtid;

template <int NT, int KS>
__device__ __forceinline__ void wave_mm(f32x4 (&acc)[NT], const LAS bf16* a, int lda, const LAS bf16* b, int ldb, int lane) {
    const int fr = lane & 15, fq = lane >> 4;
#pragma unroll
    for (int ks = 0; ks < KS; ++ks) {
        const bf16x8 af = *(const LAS bf16x8*)(a + fr * lda + ks * 32 + fq * 8);
#pragma unroll
        for (int nt = 0; nt < NT; ++nt) {
            const bf16x8 bfr = *(const LAS bf16x8*)(b + (nt * 16 + fr) * ldb + ks * 32 + fq * 8);
            acc[nt] = __builtin_amdgcn_mfma_f32_16x16x32_bf16(bfr, af, acc[nt], 0, 0, 0);
        }
    }
}

struct EpiBf {
    static constexpr bool PERM = true, AFTER_DRAIN = false;
    bf16* O; int ldc; int mode; int li; float* out;
    __device__ __forceinline__ void operator()(const f32x4 (&acc)[2][2][4][2], const pg8::Unit& u, int wr, int wc, int fr, int fq) const {
#pragma unroll
        for (int ai = 0; ai < 2; ++ai)
#pragma unroll
            for (int m = 0; m < 4; ++m) {
                const int r = u.pm * 256 + ai * 128 + wr * 64 + m * 16 + fr;
                bf16* rowp = O + (size_t)r * ldc;
#pragma unroll
                for (int bj = 0; bj < 2; ++bj) {
                    const int c = u.pn * 256 + bj * 128 + wc * 32 + 8 * fq;
                    const f32x4 v0 = acc[ai][bj][m][0], v1 = acc[ai][bj][m][1];
                    u32x4 w; w.x = pk2(v0[0], v0[1]); w.y = pk2(v0[2], v0[3]); w.z = pk2(v1[0], v1[1]); w.w = pk2(v1[2], v1[3]);
                    *(u32x4*)(rowp + c) = w;
                }
            }
        if (mode == 1 && u.pm >= 62 && (u.pn < 2 || u.pn >= 4)) {
#pragma unroll
            for (int ai = 0; ai < 2; ++ai)
#pragma unroll
                for (int m = 0; m < 4; ++m) {
                    const int r = u.pm * 256 + ai * 128 + wr * 64 + m * 16 + fr;
                    float* dst = nullptr;
                    if (u.pn < 2) {
                        if (r < SEQ) { if (r >= SEQ - 15) dst = out + O_POOLP + ((size_t)li * 15 + (r - (SEQ - 15))) * 512; }
                        else { const int b = (r - SEQ) >> 4, t = (r - SEQ) & 15; if (t >= 1) dst = out + O_POOLS + (((size_t)li * 16 + b) * 15 + (t - 1)) * 512; }
                        if (dst) dst += u.pn * 256;
                    } else {
                        const bool isv = u.pn >= 6;
                        if (r < SEQ) dst = out + (isv ? O_VP : O_KP) + ((size_t)li * 512 + (r - (SEQ - 512))) * 512;
                        else { const int b = (r - SEQ) >> 4, t = (r - SEQ) & 15; dst = out + (isv ? O_VS : O_KS) + (((size_t)li * 16 + b) * 16 + t) * 512; }
                        dst += (u.pn & 1) * 256;
                    }
                    if (dst) {
#pragma unroll
                        for (int bj = 0; bj < 2; ++bj)
#pragma unroll
                            for (int n = 0; n < 2; ++n) *(f32x4*)(dst + bj * 128 + wc * 32 + 8 * fq + 4 * n) = acc[ai][bj][m][n];
                    }
                }
        }
        if (mode == 2 && u.pm >= 63) {
#pragma unroll
            for (int ai = 0; ai < 2; ++ai)
#pragma unroll
                for (int m = 0; m < 4; ++m) {
                    const int r = u.pm * 256 + ai * 128 + wr * 64 + m * 16 + fr;
                    float* dst = nullptr;
                    if (r < SEQ) { if (r >= SEQ - 2) dst = out + O_FFNP + ((size_t)li * 2 + (r - (SEQ - 2))) * DUP; }
                    else { const int b = (r - SEQ) >> 4, t = (r - SEQ) & 15; if (t >= 14) dst = out + O_FFNS + (((size_t)li * 16 + b) * 2 + (t - 14)) * DUP; }
                    if (dst) {
                        dst += u.pn * 256;
#pragma unroll
                        for (int bj = 0; bj < 2; ++bj)
#pragma unroll
                            for (int n = 0; n < 2; ++n) *(f32x4*)(dst + bj * 128 + wc * 32 + 8 * fq + 4 * n) = acc[ai][bj][m][n];
                    }
                }
        }
    }
};
struct EpiRes {
    static constexpr bool PERM = false, AFTER_DRAIN = false;
    const float* base_p; const float* base_s; float* out; const float* gate;
    __device__ __forceinline__ void operator()(const f32x4 (&acc)[2][2][4][2], const pg8::Unit& u, int wr, int wc, int fr, int fq) const {
#pragma unroll
        for (int ai = 0; ai < 2; ++ai)
#pragma unroll
            for (int m = 0; m < 4; ++m) {
                const int r = u.pm * 256 + ai * 128 + wr * 64 + m * 16 + fr;
                const int b = r < SEQ ? 0 : 1 + ((r - SEQ) >> 4);
                const float* bp = r < SEQ ? base_p + (size_t)r * D : base_s + (size_t)(r - SEQ) * D;
                float* op = out + (size_t)r * D; const float* g = gate + b * MODW;
#pragma unroll
                for (int bj = 0; bj < 2; ++bj)
#pragma unroll
                    for (int n = 0; n < 2; ++n) {
                        const int c = u.pn * 256 + bj * 128 + wc * 32 + n * 16 + 4 * fq;
                        const f32x4 v = *(const f32x4*)(bp + c) + *(const f32x4*)(g + c) * acc[ai][bj][m][n];
                        *(f32x4*)(op + c) = v;
                    }
            }
    }
};


template <class F>
__device__ __forceinline__ void small_gemm(const bf16* A, const bf16* Bt, int N, int K, LAS unsigned char* lds, int bx, int G, int tid, int lane, int wave, F epi) {
    const int npieces = 16 * (N / 64), fr = lane & 15, fq = lane >> 4, kw = K / 8;
    LAS float* part = (LAS float*)lds;
    for (int p = bx; p < npieces; p += G) {
        const int xk = p >> 3, rg = xk & 15, cgi = (p & 7) * (N / 512) + (xk >> 4);
        const bf16* ap = A + (size_t)(rg * 16 + fr) * K + wave * kw + 8 * fq;
        const bf16* bp = Bt + (size_t)(cgi * 64 + fr) * K + wave * kw + 8 * fq;
        f32x4 acc[4];
#pragma unroll
        for (int i = 0; i < 4; ++i) acc[i] = (f32x4){0.f, 0.f, 0.f, 0.f};
#pragma unroll 4
        for (int ks = 0; ks < kw / 32; ++ks) {
            const bf16x8 af = *(const bf16x8*)(ap + ks * 32);
#pragma unroll
            for (int nt = 0; nt < 4; ++nt) { const bf16x8 bfr = *(const bf16x8*)(bp + (size_t)nt * 16 * K + ks * 32);
                acc[nt] = __builtin_amdgcn_mfma_f32_16x16x32_bf16(bfr, af, acc[nt], 0, 0, 0); }
        }
#pragma unroll
        for (int nt = 0; nt < 4; ++nt) *(LAS f32x4*)(part + wave * 1024 + fr * 64 + nt * 16 + 4 * fq) = acc[nt];
        __syncthreads();
        { const int r = tid >> 5, c2 = (tid & 31) * 2; float s0 = 0.f, s1 = 0.f;
#pragma unroll
          for (int w = 0; w < 8; ++w) { const f32x2 v = *(const LAS f32x2*)(part + w * 1024 + r * 64 + c2); s0 += v.x; s1 += v.y; }
          epi(rg * 16 + r, cgi * 64 + c2, s0, s1); }
        __syncthreads();
    }
}

__device__ __forceinline__ void p0_transpose_item(const float* W, int K, int N, bf16* WT, LAS float* scr, int item, int lane) {
    const int nblk = N / 32, kb = item / nblk, nb = item % nblk, k0 = 64 * kb, n0 = 32 * nb;
    float tv[32];
#pragma unroll
    for (int i = 0; i < 32; ++i) tv[i] = __builtin_nontemporal_load(W + (size_t)(k0 + 2 * i + (lane >> 5)) * N + n0 + (lane & 31));
#pragma unroll
    for (int i = 0; i < 32; ++i) scr[(2 * i + (lane >> 5)) * 33 + (lane & 31)] = tv[i];
    LDS_WAIT();
    const int c = lane & 7;
#pragma unroll
    for (int j = 0; j < 4; ++j) { const int n = (lane >> 3) + 8 * j; const LAS float* s = scr + (8 * c) * 33 + n;
        u32x4 o; o.x = pk2(s[0 * 33], s[1 * 33]); o.y = pk2(s[2 * 33], s[3 * 33]); o.z = pk2(s[4 * 33], s[5 * 33]); o.w = pk2(s[6 * 33], s[7 * 33]);
        *(u32x4*)(WT + (size_t)(n0 + n) * K + k0 + 8 * c) = o; }
    LDS_WAIT();
}
__device__ __forceinline__ void p0_transpose_mats(const float* W, int K, int N, bf16* WT, int nmat, LAS float* scr, int gw, int NGW, int lane) {
    const int per = (K / 64) * (N / 32), tot = per * nmat;
    for (int it = gw; it < tot; it += NGW) { const int mi = it / per, r = it % per;
        p0_transpose_item(W + (size_t)mi * K * N, K, N, WT + (size_t)mi * K * N, scr, r, lane); }
}
__device__ __forceinline__ void p0_mod_task(const Params& P, int task, LAS unsigned char* lds, int tid) {
    LAS float* CS = (LAS float*)lds;
    LAS float* RED = (LAS float*)(lds + NBT * D * 4);
    const int l = task / 48, e0 = (task % 48) * 128;
    { float cv[34];
#pragma unroll
      for (int j = 0; j < 34; ++j) { const int i = tid + j * NTHR; cv[j] = *(i < D ? P.in[I_CP] + i : P.in[I_CS] + (i - D)); }
#pragma unroll
      for (int j = 0; j < 34; ++j) CS[tid + j * NTHR] = silu_f(cv[j]); }
    __syncthreads();
    const int eq = tid & 31, dc = tid >> 5;
    f32x4 acc[NBT];
#pragma unroll
    for (int b = 0; b < NBT; ++b) acc[b] = (f32x4){0.f, 0.f, 0.f, 0.f};
    const float* wp = P.in[I_WADA] + ((size_t)l * D + dc * 64) * MODW + e0 + 4 * eq;
#pragma unroll 4
    for (int dd = 0; dd < 64; ++dd) {
        const f32x4 w = __builtin_nontemporal_load((const f32x4*)(wp + (size_t)dd * MODW));
#pragma unroll
        for (int b = 0; b < NBT; ++b) acc[b] += w * CS[b * D + dc * 64 + dd];
    }
    float* mod = (float*)(P.ws + WS_MOD);
#pragma unroll
    for (int b = 0; b < NBT; ++b) {
        *(LAS f32x4*)(RED + dc * 128 + 4 * eq) = acc[b];
        __syncthreads();
        if (tid < 128) { float s = P.in[I_BADA][l * MODW + e0 + tid];
#pragma unroll
            for (int k = 0; k < 16; ++k) s += RED[k * 128 + tid];
            mod[((size_t)l * NBT + b) * MODW + e0 + tid] = s; }
        __syncthreads();
    }
}
__device__ __forceinline__ void phase0(const Params& P, LAS unsigned char* lds, int tid, int lane, int wave) {
    const int G = gridDim.x, bx = blockIdx.x;
    for (int task = bx; task < 192; task += G) p0_mod_task(P, task, lds, tid);
    __syncthreads();
    LAS float* scr = (LAS float*)(lds + wave * 16384);
    const int gw = bx * NWAVES + wave, NGW = G * NWAVES;
    unsigned char* ws = P.ws;
    p0_transpose_mats(P.in[I_WUP], D, DUP, (bf16*)(ws + WS_WUP), 4, scr, gw, NGW, lane);
    p0_transpose_mats(P.in[I_WDN], DFF, D, (bf16*)(ws + WS_WDN), 4, scr, gw, NGW, lane);
    p0_transpose_mats(P.in[I_WINE], D, DINE, (bf16*)(ws + WS_WINE), 2, scr, gw, NGW, lane);
    p0_transpose_mats(P.in[I_WINO], D, DINO, (bf16*)(ws + WS_WINO), 2, scr, gw, NGW, lane);
    p0_transpose_mats(P.in[I_WOUTE], D, D, (bf16*)(ws + WS_WOUTE), 2, scr, gw, NGW, lane);
    p0_transpose_mats(P.in[I_WOUTO], D, D, (bf16*)(ws + WS_WOUTO), 2, scr, gw, NGW, lane);
    p0_transpose_mats(P.in[I_POOLW], 128, 128, (bf16*)(ws + WS_POOLW), 8, scr, gw, NGW, lane);
    f32x2* rope = (f32x2*)(ws + WS_ROPE);
    for (int i = bx * NTHR + tid; i < (SEQ + 16) * 32; i += G * NTHR) {
        const int pi = i >> 5, j = i & 31; const int pos = pi < SEQ ? pi : 4096 + (pi - SEQ);
        const float inv = exp2f(-(float)j * (13.287712379549449f / 32.0f));
        const float ang = (float)pos * inv;
        const double rev = (double)ang * 0.15915494309189535; const float fr = (float)(rev - floor(rev));
        rope[i] = (f32x2){__builtin_amdgcn_cosf(fr), __builtin_amdgcn_sinf(fr)};
    }
}

__device__ __forceinline__ void norm_phase(const float* xp, const float* xs, const float* nw, const float* mod, int sh_off, int sc_off, bf16* HM, int gw, int NGW, int lane) {
    f32x4 v0[4], v1[4], v2[4];
    auto rowp = [&](int m) { return m < SEQ ? xp + (size_t)m * D : xs + (size_t)(m - SEQ) * D; };
    if (gw < M) {
#pragma unroll
        for (int j = 0; j < 4; ++j) v0[j] = ((const f32x4*)rowp(gw))[lane + 64 * j]; }
    if (gw + NGW < M) {
#pragma unroll
        for (int j = 0; j < 4; ++j) v1[j] = ((const f32x4*)rowp(gw + NGW))[lane + 64 * j]; }
    for (int m = gw; m < M; m += NGW) {
        const int m2 = m + 2 * NGW;
        { const float* xr = rowp(m2 < M ? m2 : m);
#pragma unroll
          for (int j = 0; j < 4; ++j) v2[j] = ((const f32x4*)xr)[lane + 64 * j]; }
        const int b = m < SEQ ? 0 : 1 + ((m - SEQ) >> 4);
        const float* md = mod + b * MODW;
        f32x4 g[4], sc[4], sh[4];
#pragma unroll
        for (int j = 0; j < 4; ++j) { const int idx = 4 * (lane + 64 * j); g[j] = *(const f32x4*)(nw + idx); sc[j] = *(const f32x4*)(md + sc_off + idx); sh[j] = *(const f32x4*)(md + sh_off + idx); }
        float ss = 0.f;
#pragma unroll
        for (int j = 0; j < 4; ++j) ss += (v0[j].x * v0[j].x + v0[j].y * v0[j].y) + (v0[j].z * v0[j].z + v0[j].w * v0[j].w);
        const float rstd = 1.0f / sqrtf(wave_sum(ss) * (1.0f / D) + 1e-6f);
#pragma unroll
        for (int j = 0; j < 4; ++j) { const int idx = 4 * (lane + 64 * j);
            const f32x4 y = v0[j] * rstd * g[j] * (sc[j] + 1.0f) + sh[j];
            u32x2 w; w.x = pk2(y.x, y.y); w.y = pk2(y.z, y.w);
            *(u32x2*)(HM + (size_t)m * D + idx) = w; }
#pragma unroll
        for (int j = 0; j < 4; ++j) { v0[j] = v1[j]; v1[j] = v2[j]; }
    }
}
__device__ __forceinline__ void final_norm_phase(float* x, const float* nw, int gw, int NGW, int lane) {
    if (gw >= M) return;
    f32x4 v0[4], v1[4], v2[4], g[4];
#pragma unroll
    for (int j = 0; j < 4; ++j) g[j] = *(const f32x4*)(nw + 4 * (lane + 64 * j));
    auto ld = [&](f32x4 (&v)[4], int m) { const f32x4* xr = (const f32x4*)(x + (size_t)(m < M ? m : gw) * D);
#pragma unroll
        for (int j = 0; j < 4; ++j) v[j] = xr[lane + 64 * j]; };
    ld(v0, gw); ld(v1, gw + NGW);
    for (int m = gw; m < M; m += NGW) {
        ld(v2, m + 2 * NGW);
        float s = 0.f;
#pragma unroll
        for (int j = 0; j < 4; ++j) s += (v0[j].x * v0[j].x + v0[j].y * v0[j].y) + (v0[j].z * v0[j].z + v0[j].w * v0[j].w);
        const float rstd = 1.0f / sqrtf(wave_sum(s) * (1.0f / D) + 1e-6f);
        f32x4* xr = (f32x4*)(x + (size_t)m * D);
#pragma unroll
        for (int j = 0; j < 4; ++j) xr[lane + 64 * j] = v0[j] * rstd * g[j];
#pragma unroll
        for (int j = 0; j < 4; ++j) { v0[j] = v1[j]; v1[j] = v2[j]; }
    }
}

constexpr int LP = 72;
__device__ __forceinline__ void kv_unit(const bf16* PROJ, const f32x2* rope, float* KVS, int n, int hp, LAS unsigned char* lds, int tid, int lane, int wave) {
    LAS bf16* base = (LAS bf16*)lds;
#pragma unroll
    for (int it = 0; it < 2; ++it) {
        const int item = tid + it * NTHR; const int jq = item & 7, hh = (item >> 3) & 1, c = item >> 4;
        const int h = hp * 2 + hh; const int row = n * 64 + c;
        const bf16* src = PROJ + (size_t)row * DINE + 512 + h * 64 + 4 * jq;
        const u32x2 a = *(const u32x2*)src, b2 = *(const u32x2*)(src + 32);
        const float x1[4] = {bflo(a.x), bfhi(a.x), bflo(a.y), bfhi(a.y)}, x2[4] = {bflo(b2.x), bfhi(b2.x), bflo(b2.y), bfhi(b2.y)};
        const float zs = fexp2(log2_gamma(h) * (float)(63 - c)) * 0.125f;
        LAS bf16* Kt = base + hh * (2 * 64 * LP);
#pragma unroll
        for (int r = 0; r < 4; ++r) { const f32x2 cs = rope[(size_t)row * 32 + 4 * jq + r];
            Kt[(4 * jq + r) * LP + c] = f2bf((x1[r] * cs.x - x2[r] * cs.y) * zs);
            Kt[(32 + 4 * jq + r) * LP + c] = f2bf((x1[r] * cs.y + x2[r] * cs.x) * zs); }
    }
#pragma unroll
    for (int it = 0; it < 2; ++it) {
        const int item = tid + it * NTHR; const int eo = item & 7, hh = (item >> 3) & 1, s = item >> 4;
        const int h = hp * 2 + hh; const int row = n * 64 + s;
        const u32x4 v = *(const u32x4*)(PROJ + (size_t)row * DINE + 1024 + h * 64 + 8 * eo);
        LAS bf16* Vt = base + hh * (2 * 64 * LP) + 64 * LP;
        const unsigned w[4] = {v.x, v.y, v.z, v.w};
#pragma unroll
        for (int k = 0; k < 4; ++k) { Vt[(8 * eo + 2 * k) * LP + s] = (bf16)(w[k] & 0xffffu); Vt[(8 * eo + 2 * k + 1) * LP + s] = (bf16)(w[k] >> 16); }
    }
    __syncthreads();
    {
        const int hh = wave >> 2, strip = wave & 3, h = hp * 2 + hh, fr = lane & 15, fq = lane >> 4;
        const LAS bf16* Kt = base + hh * (2 * 64 * LP); const LAS bf16* Vt = Kt + 64 * LP;
        f32x4 acc[4];
#pragma unroll
        for (int i = 0; i < 4; ++i) acc[i] = (f32x4){0.f, 0.f, 0.f, 0.f};
        wave_mm<4, 2>(acc, Kt + strip * 16 * LP, LP, Vt, LP, lane);
        float* dst = KVS + (((size_t)n * 8 + h) * 64 + strip * 16 + fr) * 64 + 4 * fq;
#pragma unroll
        for (int nt = 0; nt < 4; ++nt) *(f32x4*)(dst + nt * 16) = acc[nt];
    }
    __syncthreads();
}
__device__ __forceinline__ void sconv_items(const Params& P, int li, const bf16* PROJ, bf16* MIX, int gtid, int GT) {
    const float* cw = P.in[I_SCW] + (size_t)li * 3 * 512;
    const float* sbuf = P.in[I_SSCONV] + (size_t)li * 16 * 2 * 512;
    for (int item = gtid; item < M * 64; item += GT) {
        const int co = item & 63, m = item >> 6, c = 8 * co;
        const int t = m < SEQ ? m : (m - SEQ) & 15; const int b = m < SEQ ? 0 : (m - SEQ) >> 4;
        float u[3][8];
        u32x4 gcv[3], hvv[3];
#pragma unroll
        for (int k = 0; k < 3; ++k) {
            const bf16* rp = PROJ + (size_t)(t - 2 + k >= 0 ? m - 2 + k : m) * DINE;
            gcv[k] = *(const u32x4*)(rp + 2560 + c); hvv[k] = *(const u32x4*)(rp + 3072 + c);
        }
#pragma unroll
        for (int k = 0; k < 3; ++k) {
            const unsigned g4[4] = {gcv[k].x, gcv[k].y, gcv[k].z, gcv[k].w}, h4[4] = {hvv[k].x, hvv[k].y, hvv[k].z, hvv[k].w};
            const bool valid = t - 2 + k >= 0;
#pragma unroll
            for (int q = 0; q < 4; ++q) { u[k][2 * q] = valid ? bflo(g4[q]) * bflo(h4[q]) : 0.f; u[k][2 * q + 1] = valid ? bfhi(g4[q]) * bfhi(h4[q]) : 0.f; }
        }
        if (m >= SEQ && t < 2) {
#pragma unroll
            for (int k = 0; k < 2; ++k) if (t - 2 + k < 0) { const float* sp = sbuf + ((size_t)b * 2 + (t + k)) * 512 + c;
#pragma unroll
                for (int q = 0; q < 8; ++q) u[k][q] = sp[q]; }
        }
        const u32x4 gb = *(const u32x4*)(PROJ + (size_t)m * DINE + 2048 + c);
        const unsigned gb4[4] = {gb.x, gb.y, gb.z, gb.w};
        float y[8];
#pragma unroll
        for (int q = 0; q < 8; ++q) {
            const float conv = cw[c + q] * u[0][q] + cw[512 + c + q] * u[1][q] + cw[1024 + c + q] * u[2][q];
            const float g = (q & 1) ? bfhi(gb4[q >> 1]) : bflo(gb4[q >> 1]);
            y[q] = g * conv;
        }
        u32x4 o; o.x = pk2(y[0], y[1]); o.y = pk2(y[2], y[3]); o.z = pk2(y[4], y[5]); o.w = pk2(y[6], y[7]);
        *(u32x4*)(MIX + (size_t)m * D + 512 + c) = o;
        float* dst = nullptr;
        if (m < SEQ) { if (m >= SEQ - 2) dst = P.out + O_SCP + ((size_t)li * 2 + (m - (SEQ - 2))) * 512 + c; }
        else if (t >= 14) dst = P.out + O_SCS + (((size_t)li * 16 + b) * 2 + (t - 14)) * 512 + c;
        if (dst) {
#pragma unroll
            for (int q = 0; q < 8; ++q) dst[q] = u[2][q];
        }
    }
}
__device__ __forceinline__ void scan_task(float* KVS, float* retp, int w, LAS unsigned char* lds, int tid) {
    LAS float* TOT = (LAS float*)lds;
    const int e = tid & 127, seg = tid >> 7, el = w * 128 + e, h = el >> 12;
    const float l2g = log2_gamma(h), g64 = fexp2(l2g * 64.0f), g4096 = fexp2(l2g * 4096.0f);
    float* p = KVS + (size_t)(seg * 64) * 32768 + el;
    float v[64];
#pragma unroll
    for (int k = 0; k < 64; ++k) v[k] = p[(size_t)k * 32768];
    float tot = 0.f;
#pragma unroll
    for (int k = 0; k < 64; ++k) tot = tot * g64 + v[k];
    TOT[seg * 128 + e] = tot;
    __syncthreads();
    float R = 0.f;
    for (int s = 0; s < seg; ++s) R = R * g4096 + TOT[s * 128 + e];
#pragma unroll
    for (int k = 0; k < 64; ++k) { p[(size_t)k * 32768] = R; R = R * g64 + v[k]; }
    if (seg == 3) retp[el] = R;
    __syncthreads();
}
__device__ __forceinline__ void retout_unit(const Params& P, int li, const bf16* PROJ, const f32x2* rope, const float* KVS, bf16* MIX, int n, int hp,
                                            LAS unsigned char* lds, int tid, int lane, int wave) {
    constexpr int HB = 5 * 64 * LP;
    LAS bf16* base = (LAS bf16*)lds;
#pragma unroll
    for (int it = 0; it < 4; ++it) {
        const int item = tid + it * NTHR; const int jq = item & 7, qk = (item >> 3) & 1, hh = (item >> 4) & 1, c = item >> 5;
        const int h = hp * 2 + hh; const int row = n * 64 + c;
        const bf16* src = PROJ + (size_t)row * DINE + qk * 512 + h * 64 + 4 * jq;
        const u32x2 a = *(const u32x2*)src, b2 = *(const u32x2*)(src + 32);
        const float x1[4] = {bflo(a.x), bfhi(a.x), bflo(a.y), bfhi(a.y)}, x2[4] = {bflo(b2.x), bfhi(b2.x), bflo(b2.y), bfhi(b2.y)};
        const float sc = qk ? 0.125f : 1.0f;
        float o1[4], o2[4];
#pragma unroll
        for (int r = 0; r < 4; ++r) { const f32x2 cs = rope[(size_t)row * 32 + 4 * jq + r];
            o1[r] = (x1[r] * cs.x - x2[r] * cs.y) * sc; o2[r] = (x1[r] * cs.y + x2[r] * cs.x) * sc; }
        LAS bf16* dst = base + hh * HB + qk * (64 * LP) + c * LP + 4 * jq;
        u32x2 w1, w2; w1.x = pk2(o1[0], o1[1]); w1.y = pk2(o1[2], o1[3]); w2.x = pk2(o2[0], o2[1]); w2.y = pk2(o2[2], o2[3]);
        *(LAS u32x2*)dst = w1; *(LAS u32x2*)(dst + 32) = w2;
    }
#pragma unroll
    for (int it = 0; it < 2; ++it) {
        const int item = tid + it * NTHR; const int eo = item & 7, hh = (item >> 3) & 1, s = item >> 4;
        const int h = hp * 2 + hh; const int row = n * 64 + s;
        const u32x4 v = *(const u32x4*)(PROJ + (size_t)row * DINE + 1024 + h * 64 + 8 * eo);
        LAS bf16* Vt = base + hh * HB + 2 * 64 * LP;
        const unsigned w[4] = {v.x, v.y, v.z, v.w};
#pragma unroll
        for (int k = 0; k < 4; ++k) { Vt[(8 * eo + 2 * k) * LP + s] = (bf16)(w[k] & 0xffffu); Vt[(8 * eo + 2 * k + 1) * LP + s] = (bf16)(w[k] >> 16); }
    }
#pragma unroll
    for (int it = 0; it < 4; ++it) {
        const int item = tid + it * NTHR; const int eq = item & 15, hh = (item >> 4) & 1, d = item >> 5;
        const int h = hp * 2 + hh;
        const f32x4 v = *(const f32x4*)(KVS + (((size_t)n * 8 + h) * 64 + d) * 64 + 4 * eq);
        LAS bf16* Rt = base + hh * HB + 3 * 64 * LP;
#pragma unroll
        for (int k = 0; k < 4; ++k) Rt[(4 * eq + k) * LP + d] = f2bf(v[k]);
    }
    __syncthreads();
    {
        const int hh = wave >> 2, strip = wave & 3, h = hp * 2 + hh, fr = lane & 15, fq = lane >> 4;
        const LAS bf16* Qs = base + hh * HB + strip * 16 * LP; const LAS bf16* Ks = base + hh * HB + 64 * LP;
        const LAS bf16* Vt = base + hh * HB + 2 * 64 * LP; const LAS bf16* Rt = base + hh * HB + 3 * 64 * LP;
        LAS bf16* Pw = base + hh * HB + 4 * 64 * LP + strip * 16 * LP;
        const float l2g = log2_gamma(h);
        const int t = strip * 16 + fr;
        f32x4 S[4], O1[4], O2[4];
#pragma unroll
        for (int i = 0; i < 4; ++i) { S[i] = (f32x4){0.f, 0.f, 0.f, 0.f}; O1[i] = S[i]; O2[i] = S[i]; }
        wave_mm<4, 2>(S, Qs, LP, Ks, LP, lane);
#pragma unroll
        for (int nt = 0; nt < 4; ++nt) {
            float pv[4];
#pragma unroll
            for (int r = 0; r < 4; ++r) { const int dl = t - (nt * 16 + 4 * fq + r); pv[r] = dl >= 0 ? S[nt][r] * fexp2(l2g * (float)dl) : 0.f; }
            u32x2 w; w.x = pk2(pv[0], pv[1]); w.y = pk2(pv[2], pv[3]);
            *(LAS u32x2*)(Pw + fr * LP + nt * 16 + 4 * fq) = w;
        }
        LDS_WAIT();
        wave_mm<4, 2>(O1, Pw, LP, Vt, LP, lane);
        wave_mm<4, 2>(O2, Qs, LP, Rt, LP, lane);
        const float xi = fexp2(l2g * (float)(t + 1));
        float s = 0.f;
#pragma unroll
        for (int nt = 0; nt < 4; ++nt) { O1[nt] = O1[nt] + O2[nt] * xi; s += (O1[nt][0] + O1[nt][1]) + (O1[nt][2] + O1[nt][3]); }
        s = xrow16_sum(s);
        const float mean = s * (1.0f / 64.0f); float q = 0.f;
#pragma unroll
        for (int nt = 0; nt < 4; ++nt) { O1[nt] = O1[nt] - mean; q += (O1[nt][0] * O1[nt][0] + O1[nt][1] * O1[nt][1]) + (O1[nt][2] * O1[nt][2] + O1[nt][3] * O1[nt][3]); }
        q = xrow16_sum(q);
        const float rstd = 1.0f / sqrtf(q * (1.0f / 64.0f) + 1e-6f);
        const int row = n * 64 + t;
        const float* gain = P.in[I_GN] + (size_t)li * 512 + h * 64;
#pragma unroll
        for (int nt = 0; nt < 4; ++nt) { const int e = nt * 16 + 4 * fq;
            const u32x2 gg = *(const u32x2*)(PROJ + (size_t)row * DINE + 1536 + h * 64 + e);
            const f32x4 gn = *(const f32x4*)(gain + e);
            const float g0 = silu_f(bflo(gg.x)), g1 = silu_f(bfhi(gg.x)), g2 = silu_f(bflo(gg.y)), g3 = silu_f(bfhi(gg.y));
            u32x2 w; w.x = pk2(g0 * O1[nt][0] * rstd * gn[0], g1 * O1[nt][1] * rstd * gn[1]); w.y = pk2(g2 * O1[nt][2] * rstd * gn[2], g3 * O1[nt][3] * rstd * gn[3]);
            *(u32x2*)(MIX + (size_t)row * D + h * 64 + e) = w; }
    }
    __syncthreads();
}

__device__ __forceinline__ void kv_units_pipelined(const bf16* PROJ, const f32x2* rope, float* KVS, int bx, int G, LAS unsigned char* lds, int tid, int lane, int wave) {
    LAS bf16* base = (LAS bf16*)lds;
    u32x2 ka[2], kb[2]; f32x2 cs[2][4]; u32x4 vv[2];
    auto gload = [&](int u) { const int n = u >> 2, hp = u & 3;
#pragma unroll
        for (int it = 0; it < 2; ++it) { const int item = tid + it * NTHR;
            { const int jq = item & 7, hh = (item >> 3) & 1, c = item >> 4; const int row = n * 64 + c;
              const bf16* src = PROJ + (size_t)row * DINE + 512 + (hp * 2 + hh) * 64 + 4 * jq;
              ka[it] = *(const u32x2*)src; kb[it] = *(const u32x2*)(src + 32);
#pragma unroll
              for (int r = 0; r < 4; ++r) cs[it][r] = rope[(size_t)row * 32 + 4 * jq + r]; }
            { const int eo = item & 7, hh = (item >> 3) & 1, s = item >> 4;
              vv[it] = *(const u32x4*)(PROJ + (size_t)(n * 64 + s) * DINE + 1024 + (hp * 2 + hh) * 64 + 8 * eo); } } };
    auto lstore = [&](int u) { const int hp = u & 3;
#pragma unroll
        for (int it = 0; it < 2; ++it) { const int item = tid + it * NTHR;
            { const int jq = item & 7, hh = (item >> 3) & 1, c = item >> 4; const int h = hp * 2 + hh;
              const u32x2 a = ka[it], b2 = kb[it];
              const float x1[4] = {bflo(a.x), bfhi(a.x), bflo(a.y), bfhi(a.y)}, x2[4] = {bflo(b2.x), bfhi(b2.x), bflo(b2.y), bfhi(b2.y)};
              const float zs = fexp2(log2_gamma(h) * (float)(63 - c)) * 0.125f;
              LAS bf16* Kt = base + hh * (2 * 64 * LP);
#pragma unroll
              for (int r = 0; r < 4; ++r) { const f32x2 c2 = cs[it][r];
                  Kt[(4 * jq + r) * LP + c] = f2bf((x1[r] * c2.x - x2[r] * c2.y) * zs);
                  Kt[(32 + 4 * jq + r) * LP + c] = f2bf((x1[r] * c2.y + x2[r] * c2.x) * zs); } }
            { const int eo = item & 7, hh = (item >> 3) & 1, s = item >> 4;
              LAS bf16* Vt = base + hh * (2 * 64 * LP) + 64 * LP;
              const unsigned w[4] = {vv[it].x, vv[it].y, vv[it].z, vv[it].w};
#pragma unroll
              for (int k = 0; k < 4; ++k) { Vt[(8 * eo + 2 * k) * LP + s] = (bf16)(w[k] & 0xffffu); Vt[(8 * eo + 2 * k + 1) * LP + s] = (bf16)(w[k] >> 16); } } } };
    int u = bx; if (u >= 1024) return;
    gload(u);
    for (; u < 1024; u += G) {
        lstore(u);
        __syncthreads();
        if (u + G < 1024) gload(u + G);
        {
            const int n = u >> 2, hp = u & 3, hh = wave >> 2, strip = wave & 3, h = hp * 2 + hh, fr = lane & 15, fq = lane >> 4;
            const LAS bf16* Kt = base + hh * (2 * 64 * LP); const LAS bf16* Vt = Kt + 64 * LP;
            f32x4 acc[4];
#pragma unroll
            for (int i = 0; i < 4; ++i) acc[i] = (f32x4){0.f, 0.f, 0.f, 0.f};
            wave_mm<4, 2>(acc, Kt + strip * 16 * LP, LP, Vt, LP, lane);
            float* dst = KVS + (((size_t)n * 8 + h) * 64 + strip * 16 + fr) * 64 + 4 * fq;
#pragma unroll
            for (int nt = 0; nt < 4; ++nt) *(f32x4*)(dst + nt * 16) = acc[nt];
        }
        __syncthreads();
    }
}
__device__ __forceinline__ void retout_units_pipelined(const Params& P, int li, const bf16* PROJ, const f32x2* rope, const float* KVS, bf16* MIX, int bx, int G,
                                                       LAS unsigned char* lds, int tid, int lane, int wave) {
    constexpr int HB = 5 * 64 * LP;
    LAS bf16* base = (LAS bf16*)lds;
    u32x2 qa[4], qb[4]; f32x2 cs[4][4]; u32x4 vv[2]; f32x4 rr[4];
    auto gload = [&](int u) { const int n = u >> 2, hp = u & 3;
#pragma unroll
        for (int it = 0; it < 4; ++it) { const int item = tid + it * NTHR; const int jq = item & 7, qk = (item >> 3) & 1, hh = (item >> 4) & 1, c = item >> 5; const int row = n * 64 + c;
            const bf16* src = PROJ + (size_t)row * DINE + qk * 512 + (hp * 2 + hh) * 64 + 4 * jq;
            qa[it] = *(const u32x2*)src; qb[it] = *(const u32x2*)(src + 32);
#pragma unroll
            for (int r = 0; r < 4; ++r) cs[it][r] = rope[(size_t)row * 32 + 4 * jq + r];
            { const int eq = item & 15, h2 = (item >> 4) & 1, d = item >> 5;
              rr[it] = *(const f32x4*)(KVS + (((size_t)n * 8 + hp * 2 + h2) * 64 + d) * 64 + 4 * eq); } }
#pragma unroll
        for (int it = 0; it < 2; ++it) { const int item = tid + it * NTHR; const int eo = item & 7, hh = (item >> 3) & 1, s = item >> 4;
            vv[it] = *(const u32x4*)(PROJ + (size_t)(n * 64 + s) * DINE + 1024 + (hp * 2 + hh) * 64 + 8 * eo); } };
    auto lstore = [&]() {
#pragma unroll
        for (int it = 0; it < 4; ++it) { const int item = tid + it * NTHR; const int jq = item & 7, qk = (item >> 3) & 1, hh = (item >> 4) & 1, c = item >> 5;
            const u32x2 a = qa[it], b2 = qb[it];
            const float x1[4] = {bflo(a.x), bfhi(a.x), bflo(a.y), bfhi(a.y)}, x2[4] = {bflo(b2.x), bfhi(b2.x), bflo(b2.y), bfhi(b2.y)};
            const float sc = qk ? 0.125f : 1.0f;
            float o1[4], o2[4];
#pragma unroll
            for (int r = 0; r < 4; ++r) { const f32x2 c2 = cs[it][r]; o1[r] = (x1[r] * c2.x - x2[r] * c2.y) * sc; o2[r] = (x1[r] * c2.y + x2[r] * c2.x) * sc; }
            LAS bf16* dst = base + hh * HB + qk * (64 * LP) + c * LP + 4 * jq;
            u32x2 w1, w2; w1.x = pk2(o1[0], o1[1]); w1.y = pk2(o1[2], o1[3]); w2.x = pk2(o2[0], o2[1]); w2.y = pk2(o2[2], o2[3]);
            *(LAS u32x2*)dst = w1; *(LAS u32x2*)(dst + 32) = w2;
            { const int eq = item & 15, h2 = (item >> 4) & 1, d = item >> 5; LAS bf16* Rt = base + h2 * HB + 3 * 64 * LP;
#pragma unroll
              for (int k = 0; k < 4; ++k) Rt[(4 * eq + k) * LP + d] = f2bf(rr[it][k]); } }
#pragma unroll
        for (int it = 0; it < 2; ++it) { const int item = tid + it * NTHR; const int eo = item & 7, hh = (item >> 3) & 1, s = item >> 4;
            LAS bf16* Vt = base + hh * HB + 2 * 64 * LP; const unsigned w[4] = {vv[it].x, vv[it].y, vv[it].z, vv[it].w};
#pragma unroll
            for (int k = 0; k < 4; ++k) { Vt[(8 * eo + 2 * k) * LP + s] = (bf16)(w[k] & 0xffffu); Vt[(8 * eo + 2 * k + 1) * LP + s] = (bf16)(w[k] >> 16); } } };
    int u = bx; if (u >= 1024) return;
    gload(u);
    for (; u < 1024; u += G) {
        lstore();
        __syncthreads();
        if (u + G < 1024) gload(u + G);
        {
            const int n = u >> 2, hp = u & 3, hh = wave >> 2, strip = wave & 3, h = hp * 2 + hh, fr = lane & 15, fq = lane >> 4;
            const LAS bf16* Qs = base + hh * HB + strip * 16 * LP; const LAS bf16* Ks = base + hh * HB + 64 * LP;
            const LAS bf16* Vt = base + hh * HB + 2 * 64 * LP; const LAS bf16* Rt = base + hh * HB + 3 * 64 * LP;
            LAS bf16* Pw = base + hh * HB + 4 * 64 * LP + strip * 16 * LP;
            const float l2g = log2_gamma(h);
            const int t = strip * 16 + fr;
            f32x4 S[4], O1[4], O2[4];
#pragma unroll
            for (int i = 0; i < 4; ++i) { S[i] = (f32x4){0.f, 0.f, 0.f, 0.f}; O1[i] = S[i]; O2[i] = S[i]; }
            wave_mm<4, 2>(S, Qs, LP, Ks, LP, lane);
#pragma unroll
            for (int nt = 0; nt < 4; ++nt) {
                float pv[4];
#pragma unroll
                for (int r = 0; r < 4; ++r) { const int dl = t - (nt * 16 + 4 * fq + r); pv[r] = dl >= 0 ? S[nt][r] * fexp2(l2g * (float)dl) : 0.f; }
                u32x2 w; w.x = pk2(pv[0], pv[1]); w.y = pk2(pv[2], pv[3]);
                *(LAS u32x2*)(Pw + fr * LP + nt * 16 + 4 * fq) = w;
            }
            wave_mm<4, 2>(O1, Pw, LP, Vt, LP, lane);
            wave_mm<4, 2>(O2, Qs, LP, Rt, LP, lane);
            const float xi = fexp2(l2g * (float)(t + 1));
            float s = 0.f;
#pragma unroll
            for (int nt = 0; nt < 4; ++nt) { O1[nt] = O1[nt] + O2[nt] * xi; s += (O1[nt][0] + O1[nt][1]) + (O1[nt][2] + O1[nt][3]); }
            s = xrow16_sum(s);
            const float mean = s * (1.0f / 64.0f); float q = 0.f;
#pragma unroll
            for (int nt = 0; nt < 4; ++nt) { O1[nt] = O1[nt] - mean; q += (O1[nt][0] * O1[nt][0] + O1[nt][1] * O1[nt][1]) + (O1[nt][2] * O1[nt][2] + O1[nt][3] * O1[nt][3]); }
            q = xrow16_sum(q);
            const float rstd = 1.0f / sqrtf(q * (1.0f / 64.0f) + 1e-6f);
            const int row = n * 64 + t;
            const float* gain = P.in[I_GN] + (size_t)li * 512 + h * 64;
#pragma unroll
            for (int nt = 0; nt < 4; ++nt) { const int e = nt * 16 + 4 * fq;
                const u32x2 gg = *(const u32x2*)(PROJ + (size_t)row * DINE + 1536 + h * 64 + e);
                const f32x4 gn = *(const f32x4*)(gain + e);
                const float g0 = silu_f(bflo(gg.x)), g1 = silu_f(bfhi(gg.x)), g2 = silu_f(bflo(gg.y)), g3 = silu_f(bfhi(gg.y));
                u32x2 w; w.x = pk2(g0 * O1[nt][0] * rstd * gn[0], g1 * O1[nt][1] * rstd * gn[1]); w.y = pk2(g2 * O1[nt][2] * rstd * gn[2], g3 * O1[nt][3] * rstd * gn[3]);
                *(u32x2*)(MIX + (size_t)row * D + h * 64 + e) = w; }
        }
        __syncthreads();
    }
}

__device__ __forceinline__ void retstep_unit(const Params& P, int li, const bf16* PROJ, const f32x2* rope, bf16* MIX, int b, int h, LAS unsigned char* lds, int tid, int lane, int wave) {
    LAS float* q = (LAS float*)lds; LAS float* k = q + 1024; LAS float* v = k + 1024; LAS float* S = v + 1024; LAS float* sc = S + 4096;
    const float l2g = log2_gamma(h);
    const int row0 = SEQ + b * 16;
    { const int t = tid >> 5, j = tid & 31; const bf16* rp = PROJ + (size_t)(row0 + t) * DINE + h * 64;
      const f32x2 cs = rope[(size_t)(SEQ + t) * 32 + j];
      const float q1 = bf2f(rp[j]), q2 = bf2f(rp[32 + j]), k1 = bf2f(rp[512 + j]), k2 = bf2f(rp[512 + 32 + j]);
      q[t * 64 + j] = q1 * cs.x - q2 * cs.y; q[t * 64 + 32 + j] = q1 * cs.y + q2 * cs.x;
      k[t * 64 + j] = (k1 * cs.x - k2 * cs.y) * 0.125f; k[t * 64 + 32 + j] = (k1 * cs.y + k2 * cs.x) * 0.125f;
      v[t * 64 + j] = bf2f(rp[1024 + j]); v[t * 64 + 32 + j] = bf2f(rp[1024 + 32 + j]); }
    const float* Sg = P.in[I_SRET] + (((size_t)li * 16 + b) * 8 + h) * 4096;
#pragma unroll
    for (int i = 0; i < 8; ++i) S[tid + i * NTHR] = Sg[tid + i * NTHR];
    __syncthreads();
    if (tid < 256) { const int t = tid >> 4, s = tid & 15; float a = 0.f;
        if (s <= t) { for (int d = 0; d < 64; ++d) a += q[t * 64 + d] * k[s * 64 + d]; a *= fexp2(l2g * (float)(t - s)); }
        sc[tid] = a; }
    __syncthreads();
    {
        const int t0 = wave, t1 = wave + 8, e = lane; float in0 = 0.f, in1 = 0.f, cr0 = 0.f, cr1 = 0.f;
#pragma unroll
        for (int s4 = 0; s4 < 4; ++s4) { const f32x4 sa = *(const LAS f32x4*)(sc + t0 * 16 + 4 * s4), sb = *(const LAS f32x4*)(sc + t1 * 16 + 4 * s4);
#pragma unroll
            for (int j = 0; j < 4; ++j) { const float vv = v[(4 * s4 + j) * 64 + e]; in0 += sa[j] * vv; in1 += sb[j] * vv; } }
#pragma unroll 4
        for (int d4 = 0; d4 < 16; ++d4) { const f32x4 qa = *(const LAS f32x4*)(q + t0 * 64 + 4 * d4), qb = *(const LAS f32x4*)(q + t1 * 64 + 4 * d4);
#pragma unroll
            for (int j = 0; j < 4; ++j) { const float sv = S[(4 * d4 + j) * 64 + e]; cr0 += qa[j] * sv; cr1 += qb[j] * sv; } }
#pragma unroll
        for (int tt = 0; tt < 2; ++tt) {
            const int t = tt ? t1 : t0;
            float o = (tt ? in1 : in0) + (tt ? cr1 : cr0) * fexp2(l2g * (float)(t + 1));
            const float mean = wave_sum(o) * (1.0f / 64.0f); o -= mean;
            const float rstd = 1.0f / sqrtf(wave_sum(o * o) * (1.0f / 64.0f) + 1e-6f);
            const float g = bf2f(PROJ[(size_t)(row0 + t) * DINE + 1536 + h * 64 + e]);
            MIX[(size_t)(row0 + t) * D + h * 64 + e] = f2bf(silu_f(g) * o * rstd * P.in[I_GN][li * 512 + h * 64 + e]);
        }
    }
    float* Sn = P.out + O_RETS + (((size_t)li * 16 + b) * 8 + h) * 4096;
    const float g16 = fexp2(l2g * 16.0f);
    {
        const int e = tid & 63, d0 = tid >> 6; float a[8];
#pragma unroll
        for (int i = 0; i < 8; ++i) a[i] = S[tid + i * NTHR] * g16;
#pragma unroll 4
        for (int t = 0; t < 16; ++t) { const float vz = v[t * 64 + e] * fexp2(l2g * (float)(15 - t));
#pragma unroll
            for (int i = 0; i < 8; ++i) a[i] += k[t * 64 + d0 + 8 * i] * vz; }
#pragma unroll
        for (int i = 0; i < 8; ++i) Sn[tid + i * NTHR] = a[i];
    }
    __syncthreads();
}

__device__ __forceinline__ void attn_block(f32x4 (&O)[4], float& mrun, float& lrun, const LAS bf16* Qw, const LAS bf16* Kb, const LAS bf16* Vtb, LAS bf16* Pw,
                                           const LAS float* bias, int iq, int jbase, int nvalid, int lane) {
    const int fr = lane & 15, fq = lane >> 4;
    f32x4 S[4];
#pragma unroll
    for (int i = 0; i < 4; ++i) S[i] = (f32x4){0.f, 0.f, 0.f, 0.f};
    wave_mm<4, 2>(S, Qw, LP, Kb, LP, lane);
    float mx = -1e30f;
#pragma unroll
    for (int nt = 0; nt < 4; ++nt)
#pragma unroll
        for (int r = 0; r < 4; ++r) { const int j = nt * 16 + 4 * fq + r; int rel = 512 + iq - (jbase + j); rel = rel < -63 ? -63 : (rel > 256 ? 256 : rel);
            float s = S[nt][r] * 0.125f + bias[rel + 63]; if (j >= nvalid) s = -1e30f; S[nt][r] = s; mx = fmaxf(mx, s); }
    mx = fmaxf(mx, __shfl_xor(mx, 16)); mx = fmaxf(mx, __shfl_xor(mx, 32));
    const float mnew = fmaxf(mrun, mx), alpha = __expf(mrun - mnew);
    float ps = 0.f;
#pragma unroll
    for (int nt = 0; nt < 4; ++nt) {
        float p[4];
#pragma unroll
        for (int r = 0; r < 4; ++r) { p[r] = __expf(S[nt][r] - mnew); ps += p[r]; }
        u32x2 w; w.x = pk2(p[0], p[1]); w.y = pk2(p[2], p[3]);
        *(LAS u32x2*)(Pw + fr * LP + nt * 16 + 4 * fq) = w;
        O[nt] = O[nt] * alpha;
    }
    ps += __shfl_xor(ps, 16); ps += __shfl_xor(ps, 32);
    lrun = lrun * alpha + ps; mrun = mnew;
    LDS_WAIT();
    wave_mm<4, 2>(O, Pw, LP, Vtb, LP, lane);
}
__device__ __forceinline__ void attn_prompt_unit(const Params& P, int li, const bf16* PROJ, bf16* MIX, int n, int hp, LAS unsigned char* lds, int tid, int lane, int wave) {
    constexpr int HB = 4 * 64 * LP;
    LAS bf16* base = (LAS bf16*)lds; LAS float* biasb = (LAS float*)(lds + 2 * HB * 2);
#pragma unroll
    for (int it = 0; it < 2; ++it) {
        const int item = tid + it * NTHR; const int eo = item & 7, hh = (item >> 3) & 1, c = item >> 4; const int h = hp * 2 + hh;
        *(LAS u32x4*)(base + hh * HB + c * LP + 8 * eo) = *(const u32x4*)(PROJ + (size_t)(n * 64 + c) * DINO + 512 + h * 64 + 8 * eo);
    }
    for (int i = tid; i < 640; i += NTHR) { const int hh = i / 320, k = i % 320; biasb[i] = P.in[I_REL][((size_t)li * 8 + hp * 2 + hh) * 320 + k]; }
    const int hh = wave >> 2, strip = wave & 3, h = hp * 2 + hh, fr = lane & 15, fq = lane >> 4;
    f32x4 O[4];
#pragma unroll
    for (int i = 0; i < 4; ++i) O[i] = (f32x4){0.f, 0.f, 0.f, 0.f};
    float mrun = -1e30f, lrun = 0.f;
    for (int kb = (n < 8 ? 8 - n : 0); kb <= 8; ++kb) {
        const int kc = n - 8 + kb;
        __syncthreads();
#pragma unroll
        for (int it = 0; it < 2; ++it) {
            const int item = tid + it * NTHR; const int eo = item & 7, h2 = (item >> 3) & 1, s = item >> 4; const int hd = hp * 2 + h2;
            const bf16* rp = PROJ + (size_t)(kc * 64 + s) * DINO + hd * 64 + 8 * eo;
            *(LAS u32x4*)(base + h2 * HB + 64 * LP + s * LP + 8 * eo) = *(const u32x4*)(rp + 1024);
            const u32x4 v = *(const u32x4*)(rp + 1536);
            LAS bf16* Vt = base + h2 * HB + 2 * 64 * LP;
            const unsigned w[4] = {v.x, v.y, v.z, v.w};
#pragma unroll
            for (int k = 0; k < 4; ++k) { Vt[(8 * eo + 2 * k) * LP + s] = (bf16)(w[k] & 0xffffu); Vt[(8 * eo + 2 * k + 1) * LP + s] = (bf16)(w[k] >> 16); }
        }
        __syncthreads();
        attn_block(O, mrun, lrun, base + hh * HB + strip * 16 * LP, base + hh * HB + 64 * LP, base + hh * HB + 2 * 64 * LP, base + hh * HB + 3 * 64 * LP + strip * 16 * LP,
                   biasb + hh * 320, strip * 16 + fr, kb * 64, 64, lane);
    }
    const float inv = 1.0f / lrun; const int row = n * 64 + strip * 16 + fr;
#pragma unroll
    for (int nt = 0; nt < 4; ++nt) { u32x2 w; w.x = pk2(O[nt][0] * inv, O[nt][1] * inv); w.y = pk2(O[nt][2] * inv, O[nt][3] * inv);
        *(u32x2*)(MIX + (size_t)row * D + 512 + h * 64 + nt * 16 + 4 * fq) = w; }
    __syncthreads();
}
__device__ __forceinline__ void attn_sample_unit(const Params& P, int li, const bf16* PROJ, bf16* MIX, int b, int hq, LAS unsigned char* lds, int tid, int lane, int wave) {
    constexpr int HB = (16 + 64 + 64 + 16) * LP;
    LAS bf16* base = (LAS bf16*)lds; LAS float* biasb = (LAS float*)(lds + 4 * HB * 2);
    const int row0 = SEQ + b * 16;
    { const int eo = tid & 7, h4 = (tid >> 3) & 3, t = tid >> 5;
      *(LAS u32x4*)(base + h4 * HB + t * LP + 8 * eo) = *(const u32x4*)(PROJ + (size_t)(row0 + t) * DINO + 512 + (hq * 4 + h4) * 64 + 8 * eo); }
    for (int i = tid; i < 1280; i += NTHR) { const int h4 = i / 320, k = i % 320; biasb[i] = P.in[I_REL][((size_t)li * 8 + hq * 4 + h4) * 320 + k]; }
    const int fr = lane & 15, fq = lane >> 4;
    f32x4 O[4];
#pragma unroll
    for (int i = 0; i < 4; ++i) O[i] = (f32x4){0.f, 0.f, 0.f, 0.f};
    float mrun = -1e30f, lrun = 0.f;
    const float* ck = P.in[I_CK] + ((size_t)li * 16 + b) * 512 * 512; const float* cv = P.in[I_CV] + ((size_t)li * 16 + b) * 512 * 512;
    for (int kb = 0; kb <= 8; ++kb) {
        __syncthreads();
#pragma unroll
        for (int it = 0; it < 4; ++it) {
            const int item = tid + it * NTHR; const int eo = item & 7, h4 = (item >> 3) & 3, s = item >> 5; const int hd = hq * 4 + h4;
            float kf[8], vf[8];
            if (kb < 8) {
                const float* kp = ck + (size_t)(kb * 64 + s) * 512 + hd * 64 + 8 * eo; const float* vp = cv + (size_t)(kb * 64 + s) * 512 + hd * 64 + 8 * eo;
                const f32x4 k0 = *(const f32x4*)kp, k1 = *(const f32x4*)(kp + 4), v0 = *(const f32x4*)vp, v1 = *(const f32x4*)(vp + 4);
#pragma unroll
                for (int q = 0; q < 4; ++q) { kf[q] = k0[q]; kf[4 + q] = k1[q]; vf[q] = v0[q]; vf[4 + q] = v1[q]; }
            } else if (s < 16) {
                const bf16* rp = PROJ + (size_t)(row0 + s) * DINO + hd * 64 + 8 * eo;
                const u32x4 kk = *(const u32x4*)(rp + 1024), vv = *(const u32x4*)(rp + 1536);
                const unsigned k4[4] = {kk.x, kk.y, kk.z, kk.w}, v4[4] = {vv.x, vv.y, vv.z, vv.w};
#pragma unroll
                for (int q = 0; q < 4; ++q) { kf[2 * q] = bflo(k4[q]); kf[2 * q + 1] = bfhi(k4[q]); vf[2 * q] = bflo(v4[q]); vf[2 * q + 1] = bfhi(v4[q]); }
            } else {
#pragma unroll
                for (int q = 0; q < 8; ++q) { kf[q] = 0.f; vf[q] = 0.f; }
            }
            u32x4 kw; kw.x = pk2(kf[0], kf[1]); kw.y = pk2(kf[2], kf[3]); kw.z = pk2(kf[4], kf[5]); kw.w = pk2(kf[6], kf[7]);
            *(LAS u32x4*)(base + h4 * HB + 16 * LP + s * LP + 8 * eo) = kw;
            LAS bf16* Vt = base + h4 * HB + (16 + 64) * LP;
#pragma unroll
            for (int q = 0; q < 8; ++q) Vt[(8 * eo + q) * LP + s] = f2bf(vf[q]);
        }
        __syncthreads();
        if (wave < 4)
            attn_block(O, mrun, lrun, base + wave * HB, base + wave * HB + 16 * LP, base + wave * HB + (16 + 64) * LP, base + wave * HB + (16 + 64 + 64) * LP,
                       biasb + wave * 320, fr, kb * 64, kb < 8 ? 64 : 16, lane);
    }
    if (wave < 4) {
        const float inv = 1.0f / lrun; const int row = row0 + fr, h = hq * 4 + wave;
#pragma unroll
        for (int nt = 0; nt < 4; ++nt) { u32x2 w; w.x = pk2(O[nt][0] * inv, O[nt][1] * inv); w.y = pk2(O[nt][2] * inv, O[nt][3] * inv);
            *(u32x2*)(MIX + (size_t)row * D + 512 + h * 64 + nt * 16 + 4 * fq) = w; }
    }
    __syncthreads();
}

__device__ __forceinline__ int vperm(int s) { return (s & 32) | ((s & 12) << 1) | ((s & 16) >> 2) | (s & 3); }
constexpr int EXTN = 640;
__device__ __forceinline__ void attn_block2(f32x4 (&O)[4], float& mrun, float& lrun, const bf16x8 (&qf)[2], const LAS bf16* Kb, const LAS bf16* Vtb, const LAS float* biasp, int nvalid, int lane) {
    const int fr = lane & 15, fq = lane >> 4;
    f32x4 S[4];
#pragma unroll
    for (int i = 0; i < 4; ++i) S[i] = (f32x4){0.f, 0.f, 0.f, 0.f};
#pragma unroll
    for (int ks = 0; ks < 2; ++ks)
#pragma unroll
        for (int nt = 0; nt < 4; ++nt) { const bf16x8 kf = *(const LAS bf16x8*)(Kb + (nt * 16 + fr) * LP + ks * 32 + 8 * fq);
            S[nt] = __builtin_amdgcn_mfma_f32_16x16x32_bf16(kf, qf[ks], S[nt], 0, 0, 0); }
    float mx = -1e30f;
#pragma unroll
    for (int nt = 0; nt < 4; ++nt)
#pragma unroll
        for (int r = 0; r < 4; ++r) { float s = S[nt][r] * 0.18033688011112042f + biasp[51 - nt * 16 - r];
            if (nvalid < 64 && nt * 16 + 4 * fq + r >= nvalid) s = -1e30f;
            S[nt][r] = s; mx = fmaxf(mx, s); }
    mx = xrow16_max(mx);
    if (__builtin_amdgcn_ballot_w64(mx - mrun > 8.0f) != 0ull) {
        const float mnew = fmaxf(mrun, mx), alpha = __builtin_amdgcn_exp2f(mrun - mnew);
#pragma unroll
        for (int nt = 0; nt < 4; ++nt) O[nt] = O[nt] * alpha;
        lrun *= alpha; mrun = mnew;
    }
    float ps = 0.f;
#pragma unroll
    for (int nt = 0; nt < 4; ++nt)
#pragma unroll
        for (int r = 0; r < 4; ++r) { const float p = __builtin_amdgcn_exp2f(S[nt][r] - mrun); S[nt][r] = p; ps += p; }
    lrun += ps;
    bf16x8 pf[2];
#pragma unroll
    for (int ks = 0; ks < 2; ++ks) { u32x4 w; w.x = pk2(S[2 * ks][0], S[2 * ks][1]); w.y = pk2(S[2 * ks][2], S[2 * ks][3]); w.z = pk2(S[2 * ks + 1][0], S[2 * ks + 1][1]); w.w = pk2(S[2 * ks + 1][2], S[2 * ks + 1][3]);
        pf[ks] = __builtin_bit_cast(bf16x8, w); }
#pragma unroll
    for (int ks = 0; ks < 2; ++ks)
#pragma unroll
        for (int nt = 0; nt < 4; ++nt) { const bf16x8 vf = *(const LAS bf16x8*)(Vtb + (nt * 16 + fr) * LP + ks * 32 + 8 * fq);
            O[nt] = __builtin_amdgcn_mfma_f32_16x16x32_bf16(vf, pf[ks], O[nt], 0, 0, 0); }
}
__device__ __forceinline__ void attn_prompt_unit2(const Params& P, int li, const bf16* PROJ, bf16* MIX, int g, int hp, LAS unsigned char* lds, int tid, int lane, int wave) {
    constexpr int HBUF = 2 * 64 * LP;
    LAS bf16* base = (LAS bf16*)lds; LAS float* ext = (LAS float*)(lds + 4 * HBUF * 2);
    const int n0 = 4 * g, jstart = n0 < 8 ? 8 - n0 : 0;
    const int hh = wave >> 2, sw = wave & 3, h = hp * 2 + hh, fr = lane & 15, fq = lane >> 4;
    for (int i = tid; i < 2 * EXTN; i += NTHR) { const int h2 = i / EXTN, k = i % EXTN; ext[i] = P.in[I_REL][((size_t)li * 8 + hp * 2 + h2) * 320 + (k < 319 ? k : 319)] * 1.4426950408889634f; }
    bf16x8 qf[4][2];
#pragma unroll
    for (int qc = 0; qc < 4; ++qc)
#pragma unroll
        for (int ks = 0; ks < 2; ++ks) qf[qc][ks] = *(const bf16x8*)(PROJ + (size_t)((n0 + qc) * 64 + sw * 16 + fr) * DINO + 512 + h * 64 + ks * 32 + 8 * fq);
    u32x4 kreg[2], vreg[2];
    auto gload = [&](int j) {
        const int kc = n0 - 8 + j;
#pragma unroll
        for (int it = 0; it < 2; ++it) { const int item = tid + it * NTHR;
            { const int eo = item & 7, s = (item >> 3) & 63, h2 = item >> 9; kreg[it] = *(const u32x4*)(PROJ + (size_t)(kc * 64 + s) * DINO + 1024 + (hp * 2 + h2) * 64 + 8 * eo); }
            { const int s = item & 63, eo = (item >> 6) & 7, h2 = item >> 9; vreg[it] = *(const u32x4*)(PROJ + (size_t)(kc * 64 + s) * DINO + 1536 + (hp * 2 + h2) * 64 + 8 * eo); } } };
    auto lstore = [&](int buf) {
#pragma unroll
        for (int it = 0; it < 2; ++it) { const int item = tid + it * NTHR;
            { const int eo = item & 7, s = (item >> 3) & 63, h2 = item >> 9; *(LAS u32x4*)(base + (buf * 2 + h2) * HBUF + s * LP + 8 * eo) = kreg[it]; }
            { const int s = item & 63, eo = (item >> 6) & 7, h2 = item >> 9; LAS bf16* Vt = base + (buf * 2 + h2) * HBUF + 64 * LP + vperm(s);
              const unsigned w[4] = {vreg[it].x, vreg[it].y, vreg[it].z, vreg[it].w};
#pragma unroll
              for (int k = 0; k < 4; ++k) { Vt[(8 * eo + 2 * k) * LP] = (bf16)(w[k] & 0xffffu); Vt[(8 * eo + 2 * k + 1) * LP] = (bf16)(w[k] >> 16); } } } };
    f32x4 O[4][4]; float mrun[4], lrun[4];
#pragma unroll
    for (int qc = 0; qc < 4; ++qc) { mrun[qc] = -1e30f; lrun[qc] = 0.f;
#pragma unroll
        for (int i = 0; i < 4; ++i) O[qc][i] = (f32x4){0.f, 0.f, 0.f, 0.f}; }
    gload(jstart); lstore(jstart & 1);
    __syncthreads();
    for (int j = jstart; j <= 11; ++j) {
        if (j < 11) gload(j + 1);
        const LAS bf16* Kb = base + ((j & 1) * 2 + hh) * HBUF; const LAS bf16* Vtb = Kb + 64 * LP;
#pragma unroll
        for (int qc = 0; qc < 4; ++qc)
            if (qc <= j && j <= qc + 8)
                attn_block2(O[qc], mrun[qc], lrun[qc], qf[qc], Kb, Vtb, ext + hh * EXTN + (qc + 8 - j) * 64 + sw * 16 + 12 + fr - 4 * fq, 64, lane);
        if (j < 11) lstore((j + 1) & 1);
        __syncthreads();
    }
#pragma unroll
    for (int qc = 0; qc < 4; ++qc) { float lt = xrow16_sum(lrun[qc]); const float inv = __builtin_amdgcn_rcpf(lt); const int row = (n0 + qc) * 64 + sw * 16 + fr;
#pragma unroll
        for (int nt = 0; nt < 4; ++nt) { u32x2 w; w.x = pk2(O[qc][nt][0] * inv, O[qc][nt][1] * inv); w.y = pk2(O[qc][nt][2] * inv, O[qc][nt][3] * inv);
            *(u32x2*)(MIX + (size_t)row * D + 512 + h * 64 + nt * 16 + 4 * fq) = w; } }
}
__device__ __forceinline__ void attn_sample_unit2(const Params& P, int li, const bf16* PROJ, bf16* MIX, int b, int hq, LAS unsigned char* lds, int tid, int lane, int wave) {
    constexpr int HB = 2 * 64 * LP;
    LAS bf16* base = (LAS bf16*)lds; LAS float* ext = (LAS float*)(lds + 4 * HB * 2);
    const int row0 = SEQ + b * 16, fr = lane & 15, fq = lane >> 4;
    for (int i = tid; i < 4 * EXTN; i += NTHR) { const int h4 = i / EXTN, k = i % EXTN; ext[i] = P.in[I_REL][((size_t)li * 8 + hq * 4 + h4) * 320 + (k < 319 ? k : 319)] * 1.4426950408889634f; }
    bf16x8 qf[2];
#pragma unroll
    for (int ks = 0; ks < 2; ++ks) qf[ks] = *(const bf16x8*)(PROJ + (size_t)(row0 + fr) * DINO + 512 + (hq * 4 + (wave & 3)) * 64 + ks * 32 + 8 * fq);
    f32x4 O[4];
#pragma unroll
    for (int i = 0; i < 4; ++i) O[i] = (f32x4){0.f, 0.f, 0.f, 0.f};
    float mrun = -1e30f, lrun = 0.f;
    const float* ck = P.in[I_CK] + ((size_t)li * 16 + b) * 512 * 512; const float* cv = P.in[I_CV] + ((size_t)li * 16 + b) * 512 * 512;
    for (int kb = 0; kb <= 8; ++kb) {
        __syncthreads();
#pragma unroll
        for (int it = 0; it < 4; ++it) {
            const int item = tid + it * NTHR; const int eo = item & 7, h4 = (item >> 3) & 3, s = item >> 5; const int hd = hq * 4 + h4;
            float kf[8], vf[8];
            if (kb < 8) {
                const float* kp = ck + (size_t)(kb * 64 + s) * 512 + hd * 64 + 8 * eo; const float* vp = cv + (size_t)(kb * 64 + s) * 512 + hd * 64 + 8 * eo;
                const f32x4 k0 = *(const f32x4*)kp, k1 = *(const f32x4*)(kp + 4), v0 = *(const f32x4*)vp, v1 = *(const f32x4*)(vp + 4);
#pragma unroll
                for (int q = 0; q < 4; ++q) { kf[q] = k0[q]; kf[4 + q] = k1[q]; vf[q] = v0[q]; vf[4 + q] = v1[q]; }
            } else if (s < 16) {
                const bf16* rp = PROJ + (size_t)(row0 + s) * DINO + hd * 64 + 8 * eo;
                const u32x4 kk = *(const u32x4*)(rp + 1024), vv = *(const u32x4*)(rp + 1536);
                const unsigned k4[4] = {kk.x, kk.y, kk.z, kk.w}, v4[4] = {vv.x, vv.y, vv.z, vv.w};
#pragma unroll
                for (int q = 0; q < 4; ++q) { kf[2 * q] = bflo(k4[q]); kf[2 * q + 1] = bfhi(k4[q]); vf[2 * q] = bflo(v4[q]); vf[2 * q + 1] = bfhi(v4[q]); }
            } else {
#pragma unroll
                for (int q = 0; q < 8; ++q) { kf[q] = 0.f; vf[q] = 0.f; }
            }
            u32x4 kw; kw.x = pk2(kf[0], kf[1]); kw.y = pk2(kf[2], kf[3]); kw.z = pk2(kf[4], kf[5]); kw.w = pk2(kf[6], kf[7]);
            *(LAS u32x4*)(base + h4 * HB + s * LP + 8 * eo) = kw;
            LAS bf16* Vt = base + h4 * HB + 64 * LP + vperm(s);
#pragma unroll
            for (int q = 0; q < 8; ++q) Vt[(8 * eo + q) * LP] = f2bf(vf[q]);
        }
        __syncthreads();
        if (wave < 4)
            attn_block2(O, mrun, lrun, qf, base + wave * HB, base + wave * HB + 64 * LP, ext + wave * EXTN + 512 - kb * 64 + 12 + fr - 4 * fq, kb < 8 ? 64 : 16, lane);
    }
    if (wave < 4) {
        const float inv = 1.0f / lrun; const int row = row0 + fr, h = hq * 4 + wave;
#pragma unroll
        for (int nt = 0; nt < 4; ++nt) { u32x2 w; w.x = pk2(O[nt][0] * inv, O[nt][1] * inv); w.y = pk2(O[nt][2] * inv, O[nt][3] * inv);
            *(u32x2*)(MIX + (size_t)row * D + 512 + h * 64 + nt * 16 + 4 * fq) = w; }
    }
    __syncthreads();
}


__device__ __forceinline__ void attn_sample_unit3(const Params& P, int li, const bf16* PROJ, bf16* MIX, int b, int hp, LAS unsigned char* lds, int tid, int lane, int wave) {
    constexpr int HBUF = 2 * 64 * LP;
    LAS bf16* base = (LAS bf16*)lds; LAS float* ext = (LAS float*)(lds + 4 * HBUF * 2);
    const int row0 = SEQ + b * 16, fr = lane & 15, fq = lane >> 4;
    for (int i = tid; i < 2 * EXTN; i += NTHR) { const int h2 = i / EXTN, k = i % EXTN; ext[i] = P.in[I_REL][((size_t)li * 8 + hp * 2 + h2) * 320 + (k < 319 ? k : 319)] * 1.4426950408889634f; }
    bf16x8 qf[2];
#pragma unroll
    for (int ks = 0; ks < 2; ++ks) qf[ks] = *(const bf16x8*)(PROJ + (size_t)(row0 + fr) * DINO + 512 + (hp * 2 + (wave & 1)) * 64 + ks * 32 + 8 * fq);
    const float* ck = P.in[I_CK] + ((size_t)li * 16 + b) * 512 * 512; const float* cv = P.in[I_CV] + ((size_t)li * 16 + b) * 512 * 512;
    f32x4 kr[4], vr[4];
    auto gload = [&](int kb) {
#pragma unroll
        for (int it = 0; it < 2; ++it) { const int item = tid + it * NTHR;
            { const int eo = item & 7, s = (item >> 3) & 63, h2 = item >> 9; const int col = (hp * 2 + h2) * 64 + 8 * eo;
              if (kb < 8) { const float* p = ck + (size_t)(kb * 64 + s) * 512 + col; kr[2 * it] = *(const f32x4*)p; kr[2 * it + 1] = *(const f32x4*)(p + 4); }
              else if (s < 16) { const u32x4 w = *(const u32x4*)(PROJ + (size_t)(row0 + s) * DINO + 1024 + col);
                  kr[2 * it] = (f32x4){bflo(w.x), bfhi(w.x), bflo(w.y), bfhi(w.y)}; kr[2 * it + 1] = (f32x4){bflo(w.z), bfhi(w.z), bflo(w.w), bfhi(w.w)}; }
              else { kr[2 * it] = (f32x4){0.f, 0.f, 0.f, 0.f}; kr[2 * it + 1] = kr[2 * it]; } }
            { const int s = item & 63, eo = (item >> 6) & 7, h2 = item >> 9; const int col = (hp * 2 + h2) * 64 + 8 * eo;
              if (kb < 8) { const float* p = cv + (size_t)(kb * 64 + s) * 512 + col; vr[2 * it] = *(const f32x4*)p; vr[2 * it + 1] = *(const f32x4*)(p + 4); }
              else if (s < 16) { const u32x4 w = *(const u32x4*)(PROJ + (size_t)(row0 + s) * DINO + 1536 + col);
                  vr[2 * it] = (f32x4){bflo(w.x), bfhi(w.x), bflo(w.y), bfhi(w.y)}; vr[2 * it + 1] = (f32x4){bflo(w.z), bfhi(w.z), bflo(w.w), bfhi(w.w)}; }
              else { vr[2 * it] = (f32x4){0.f, 0.f, 0.f, 0.f}; vr[2 * it + 1] = vr[2 * it]; } } } };
    auto lstore = [&](int buf) {
#pragma unroll
        for (int it = 0; it < 2; ++it) { const int item = tid + it * NTHR;
            { const int eo = item & 7, s = (item >> 3) & 63, h2 = item >> 9; const f32x4 a = kr[2 * it], c = kr[2 * it + 1];
              u32x4 w; w.x = pk2(a[0], a[1]); w.y = pk2(a[2], a[3]); w.z = pk2(c[0], c[1]); w.w = pk2(c[2], c[3]);
              *(LAS u32x4*)(base + (buf * 2 + h2) * HBUF + s * LP + 8 * eo) = w; }
            { const int s = item & 63, eo = (item >> 6) & 7, h2 = item >> 9; LAS bf16* Vt = base + (buf * 2 + h2) * HBUF + 64 * LP + vperm(s);
              const f32x4 a = vr[2 * it], c = vr[2 * it + 1];
#pragma unroll
              for (int q = 0; q < 4; ++q) { Vt[(8 * eo + q) * LP] = f2bf(a[q]); Vt[(8 * eo + 4 + q) * LP] = f2bf(c[q]); } } } };
    f32x4 O[4];
#pragma unroll
    for (int i = 0; i < 4; ++i) O[i] = (f32x4){0.f, 0.f, 0.f, 0.f};
    float mrun = -1e30f, lrun = 0.f;
    gload(0); lstore(0);
    __syncthreads();
    for (int kb = 0; kb <= 8; ++kb) {
        if (kb < 8) gload(kb + 1);
        if (wave < 2) {
            const LAS bf16* Kb = base + ((kb & 1) * 2 + wave) * HBUF;
            attn_block2(O, mrun, lrun, qf, Kb, Kb + 64 * LP, ext + wave * EXTN + 512 - kb * 64 + 12 + fr - 4 * fq, kb < 8 ? 64 : 16, lane);
        }
        if (kb < 8) lstore((kb + 1) & 1);
        __syncthreads();
    }
    if (wave < 2) {
        float lt = xrow16_sum(lrun); const float inv = __builtin_amdgcn_rcpf(lt); const int row = row0 + fr, h = hp * 2 + wave;
#pragma unroll
        for (int nt = 0; nt < 4; ++nt) { u32x2 w; w.x = pk2(O[nt][0] * inv, O[nt][1] * inv); w.y = pk2(O[nt][2] * inv, O[nt][3] * inv);
            *(u32x2*)(MIX + (size_t)row * D + 512 + h * 64 + nt * 16 + 4 * fq) = w; }
    }
}

__device__ __forceinline__ void pool_unit(const Params& P, int li, const bf16* PROJ, const bf16* PWt, bf16* MIX, int rt, int g, LAS unsigned char* lds, int tid, int lane, int wave) {
    constexpr int PP = 136;
    LAS bf16* A = (LAS bf16*)lds; LAS bf16* Bt = A + 64 * PP;
    const bf16* pw = PWt + ((size_t)li * 4 + g) * 128 * 128;
#pragma unroll
    for (int it = 0; it < 4; ++it) { const int item = tid + it * NTHR; const int co = item & 15, d = item >> 4;
        *(LAS u32x4*)(Bt + d * PP + 8 * co) = *(const u32x4*)(pw + d * 128 + 8 * co); }
    {
        const int c = tid & 127, rq = tid >> 7;
        const int m0 = rt * 64 + rq * 16;
        const bool samp = m0 >= SEQ; const int b = samp ? (m0 - SEQ) >> 4 : 0;
        const int t0 = samp ? 0 : m0;
        const bf16* colp = PROJ + (size_t)m0 * DINO + g * 128 + c;
        const float* sp = P.in[I_SPOOL] + ((size_t)li * 16 + b) * 15 * 512 + g * 128 + c;
        float xv[31];
#pragma unroll
        for (int i = 15; i < 31; ++i) xv[i] = bf2f(colp[(ptrdiff_t)(i - 15) * DINO]);
        if (samp) {
#pragma unroll
            for (int i = 0; i < 15; ++i) xv[i] = sp[(size_t)i * 512];
        } else {
#pragma unroll
            for (int i = 0; i < 15; ++i) { const int tl = t0 - 15 + i; const float v = bf2f(colp[(ptrdiff_t)((tl >= 0 ? tl : 0) - t0) * DINO]); xv[i] = tl >= 0 ? v : 0.f; }
        }
        const int w = 2 << g;
        float ps[32]; ps[0] = 0.f;
#pragma unroll
        for (int j = 0; j < 31; ++j) ps[j + 1] = ps[j] + xv[j];
        float ws[16];
        if (g == 0) {
#pragma unroll
            for (int k = 0; k < 16; ++k) ws[k] = ps[16 + k] - ps[14 + k];
        } else if (g == 1) {
#pragma unroll
            for (int k = 0; k < 16; ++k) ws[k] = ps[16 + k] - ps[12 + k];
        } else if (g == 2) {
#pragma unroll
            for (int k = 0; k < 16; ++k) ws[k] = ps[16 + k] - ps[8 + k];
        } else {
#pragma unroll
            for (int k = 0; k < 16; ++k) ws[k] = ps[16 + k] - ps[k];
        }
#pragma unroll
        for (int k = 0; k < 16; ++k) {
            const int tl = t0 + k;
            const float cnt = samp ? (float)w : (float)(tl + 1 < w ? tl + 1 : w);
            A[(rq * 16 + k) * PP + c] = f2bf(ws[k] * __builtin_amdgcn_rcpf(cnt) - xv[15 + k]);
        }
    }
    __syncthreads();
    {
        const int strip = wave & 3, ch = wave >> 2, fr = lane & 15, fq = lane >> 4;
        f32x4 acc[4];
#pragma unroll
        for (int i = 0; i < 4; ++i) acc[i] = (f32x4){0.f, 0.f, 0.f, 0.f};
        wave_mm<4, 4>(acc, A + strip * 16 * PP, PP, Bt + ch * 64 * PP, PP, lane);
        const int row = rt * 64 + strip * 16 + fr;
        const float* ps = P.in[I_POOLS] + (size_t)li * 512 + g * 128 + ch * 64;
#pragma unroll
        for (int nt = 0; nt < 4; ++nt) { const f32x4 sc = *(const f32x4*)(ps + nt * 16 + 4 * fq);
            u32x2 w; w.x = pk2(acc[nt][0] * sc[0], acc[nt][1] * sc[1]); w.y = pk2(acc[nt][2] * sc[2], acc[nt][3] * sc[3]);
            *(u32x2*)(MIX + (size_t)row * D + g * 128 + ch * 64 + nt * 16 + 4 * fq) = w; }
    }
    __syncthreads();
}

__device__ __forceinline__ void convgate_items(const Params& P, int l, const bf16* UP, bf16* ACT, int gtid, int GT) {
    const float* cw = P.in[I_FCONV] + (size_t)l * 3 * DUP;
    constexpr int NCO = DFF / 8, NRB = M / 8;
    for (int item = gtid; item < NRB * NCO; item += GT) {
        const int co = item % NCO, rb = item / NCO, c = 8 * co, m0 = rb * 8;
        const bool samp = m0 >= SEQ; const int b = samp ? (m0 - SEQ) >> 4 : 0; const int t0 = samp ? (m0 - SEQ) & 15 : m0;
        float wa[3][8], wb[3][8];
#pragma unroll
        for (int j = 0; j < 3; ++j)
#pragma unroll
            for (int q = 0; q < 8; ++q) { wa[j][q] = cw[j * DUP + c + q]; wb[j][q] = cw[j * DUP + DFF + c + q]; }
        float ua[3][8], ub[3][8];
        u32x4 ra[10], rbv[10];
#pragma unroll
        for (int k = 0; k < 10; ++k) {
            const bf16* rp = UP + (size_t)((k < 2 && t0 == 0) ? m0 : m0 - 2 + k) * DUP + c;
            ra[k] = *(const u32x4*)rp; rbv[k] = *(const u32x4*)(rp + DFF);
        }
#pragma unroll
        for (int k = 0; k < 2; ++k) {
            const unsigned a4[4] = {ra[k].x, ra[k].y, ra[k].z, ra[k].w}, b4[4] = {rbv[k].x, rbv[k].y, rbv[k].z, rbv[k].w};
#pragma unroll
            for (int q = 0; q < 4; ++q) { ua[k][2 * q] = t0 > 0 ? bflo(a4[q]) : 0.f; ua[k][2 * q + 1] = t0 > 0 ? bfhi(a4[q]) : 0.f; ub[k][2 * q] = t0 > 0 ? bflo(b4[q]) : 0.f; ub[k][2 * q + 1] = t0 > 0 ? bfhi(b4[q]) : 0.f; }
        }
        if (samp && t0 == 0) {
#pragma unroll
            for (int k = 0; k < 2; ++k) { const float* sp = P.in[I_SFFN] + (((size_t)l * 16 + b) * 2 + k) * DUP + c;
#pragma unroll
                for (int q = 0; q < 8; ++q) { ua[k][q] = sp[q]; ub[k][q] = sp[DFF + q]; } }
        }
#pragma unroll
        for (int r = 0; r < 8; ++r) {
            const unsigned a4[4] = {ra[r + 2].x, ra[r + 2].y, ra[r + 2].z, ra[r + 2].w}, b4[4] = {rbv[r + 2].x, rbv[r + 2].y, rbv[r + 2].z, rbv[r + 2].w};
#pragma unroll
            for (int q = 0; q < 4; ++q) { ua[2][2 * q] = bflo(a4[q]); ua[2][2 * q + 1] = bfhi(a4[q]); ub[2][2 * q] = bflo(b4[q]); ub[2][2 * q + 1] = bfhi(b4[q]); }
            float y[8];
#pragma unroll
            for (int q = 0; q < 8; ++q) {
                const float av = wa[0][q] * ua[0][q] + wa[1][q] * ua[1][q] + wa[2][q] * ua[2][q];
                const float bv = wb[0][q] * ub[0][q] + wb[1][q] * ub[1][q] + wb[2][q] * ub[2][q];
                y[q] = silu_f(av) * bv;
                ua[0][q] = ua[1][q]; ua[1][q] = ua[2][q]; ub[0][q] = ub[1][q]; ub[1][q] = ub[2][q];
            }
            u32x4 o; o.x = pk2(y[0], y[1]); o.y = pk2(y[2], y[3]); o.z = pk2(y[4], y[5]); o.w = pk2(y[6], y[7]);
            *(u32x4*)(ACT + (size_t)(m0 + r) * DFF + c) = o;
        }
    }
}


#define XB_TMO      128
#define XB_XCNT(j)  (256  + 64 * (j))
#define XB_XSUB(j)  (1280 + 64 * (j))
#define XB_XGEN(j)  (2304 + 64 * (j))
#define XB_TOP      3328
#define XB_TOPGEN   3392
#define XCD_BAR_WORDS 3456
#define XB_SPIN_CAP (1u << 18)

__device__ __forceinline__ unsigned xb_ld(unsigned* p)              { return __hip_atomic_load(p, __ATOMIC_RELAXED, __HIP_MEMORY_SCOPE_AGENT); }
__device__ __forceinline__ unsigned xb_add(unsigned* p, unsigned v) { return __hip_atomic_fetch_add(p, v, __ATOMIC_RELAXED, __HIP_MEMORY_SCOPE_AGENT); }
__device__ __forceinline__ unsigned xb_xcc_id() { return (unsigned)__builtin_amdgcn_s_getreg((3 << 11) | 20) & 0xFu; }
#define XB_SPIN(cond, bar) do { unsigned _sp = 0; while (cond) { __builtin_amdgcn_s_sleep(1); \
    if ((++_sp & 255u) == 0u) { if (xb_ld(&(bar)[XB_TMO])) break; if (_sp > XB_SPIN_CAP) { atomicAdd(&(bar)[XB_TMO], 1u); break; } } } } while (0)

struct XcdBarrier {
    unsigned* bar; unsigned x;
    volatile LAS unsigned* st;
};

__device__ __forceinline__ XcdBarrier xcd_barrier_post(unsigned* bar, volatile LAS unsigned* st) {
    XcdBarrier b; b.bar = bar; b.x = xb_xcc_id(); b.st = st;
    if (threadIdx.x == 0) (void)xb_add(&bar[XB_XCNT(b.x)], 1u);
    return b;
}
__device__ __forceinline__ void xcd_barrier_complete(unsigned* bar, unsigned x, unsigned& nloc, unsigned& nx) {
    const unsigned G = gridDim.x * gridDim.y * gridDim.z;
    unsigned sum, cnt, mine, sp = 0u;
    for (;;) {
        sum = 0u; cnt = 0u; mine = 0u;
#pragma unroll
        for (unsigned j = 0; j < 16; ++j) { const unsigned c = xb_ld(&bar[XB_XCNT(j)]); sum += c; cnt += (c > 0u) ? 1u : 0u; mine = (j == x) ? c : mine; }
        if (sum == G) break;
        __builtin_amdgcn_s_sleep(1);
        if ((++sp & 255u) == 0u) { if (xb_ld(&bar[XB_TMO])) break; if (sp > XB_SPIN_CAP) { atomicAdd(&bar[XB_TMO], 1u); break; } }
    }
    nloc = mine > 0u ? mine : 1u; nx = cnt > 0u ? cnt : 1u;
}

__device__ __forceinline__ void xcd_barrier(const XcdBarrier& b) {
    asm volatile("s_waitcnt vmcnt(0)" ::: "memory");
    __syncthreads();
    if (threadIdx.x == 0) {
        unsigned* bar = b.bar;
        __builtin_amdgcn_s_waitcnt(0);
        unsigned nloc = b.st[0], nx = b.st[1];
        if (nloc == 0u) { xcd_barrier_complete(bar, b.x, nloc, nx); b.st[0] = nloc; b.st[1] = nx; }
        const unsigned old = xb_add(&bar[XB_XSUB(b.x)], 1u);
        const unsigned gen = old / nloc;
        if (old + 1u == (gen + 1u) * nloc) {
            __builtin_amdgcn_fence(__ATOMIC_RELEASE, "agent");
            asm volatile("s_waitcnt vmcnt(0)" ::: "memory");
            const unsigned og = xb_add(&bar[XB_TOP], 1u);
            const unsigned tg = og / nx;
            if (og + 1u == (tg + 1u) * nx) xb_add(&bar[XB_TOPGEN], 1u);
            else XB_SPIN(xb_ld(&bar[XB_TOPGEN]) == tg, bar);
            __builtin_amdgcn_fence(__ATOMIC_ACQUIRE, "agent");
            xb_add(&bar[XB_XGEN(b.x)], 1u);
            asm volatile("s_waitcnt vmcnt(0)" ::: "memory");
        } else {
            XB_SPIN(xb_ld(&bar[XB_XGEN(b.x)]) == gen, bar);
            __builtin_amdgcn_fence(__ATOMIC_ACQUIRE, "agent");
            asm volatile("s_waitcnt vmcnt(0)" ::: "memory");
        }
    }
    __syncthreads();
}
__global__ void __launch_bounds__(NTHR) mega_fwd(Params P) {
    extern __shared__ __attribute__((aligned(16))) unsigned char lds_raw[];
    cg::grid_group grid = cg::this_grid();
    LAS unsigned char* lds = (LAS unsigned char*)lds_raw;
    const int G = gridDim.x, bx = blockIdx.x;
    const int NGW = G * NWAVES, GT = G * NTHR;
    unsigned char* ws = P.ws;
    bf16* HM = (bf16*)(ws + WS_HM); bf16* MIX = (bf16*)(ws + WS_MIX); bf16* ACT = (bf16*)(ws + WS_HM);
    bf16* R1 = (bf16*)(ws + WS_R1); float* KVS = (float*)(ws + WS_KVS);
    float* MOD = (float*)(ws + WS_MOD); const f32x2* rope = (const f32x2*)(ws + WS_ROPE);
    float* X = P.out;
    volatile LAS unsigned* MISC = (volatile LAS unsigned*)(lds + 131072 + 512);
    unsigned* barw = (unsigned*)(ws + WS_CTL);
    if (threadIdx.x < 2) MISC[threadIdx.x] = 0u;
    if (bx == 0) for (int i = threadIdx.x; i < XCD_BAR_WORDS; i += NTHR) barw[i] = 0u;
    __syncthreads();

    { PHASE_IDS phase0(P, lds, tid, lane, wave); }
    grid.sync();
    const XcdBarrier xbar = xcd_barrier_post(barw, MISC);

    for (int l = 0; l < 4; ++l) {
        const int li = l >> 1; const bool even = (l & 1) == 0;
        const float* modl = MOD + (size_t)l * NBT * MODW;
        for (int half = 0; half < 2; ++half) {
            const bool first = (l == 0 && half == 0);
            const float* xp = first ? P.in[I_XP] : X; const float* xs = first ? P.in[I_XS] : X + (size_t)SEQ * D;
            { PHASE_IDS norm_phase(xp, xs, (half == 0 ? P.in[I_NMIX] : P.in[I_NFFN]) + (size_t)l * D, modl, half * 3072, half * 3072 + 1024, HM, gw, NGW, lane); }
            xcd_barrier(xbar);
            {
                const int N = half == 1 ? DUP : (even ? DINE : DINO);
                const bf16* Wt = half == 1 ? (const bf16*)(ws + WS_WUP) + (size_t)l * DUP * D
                                           : (even ? (const bf16*)(ws + WS_WINE) + (size_t)li * DINE * D : (const bf16*)(ws + WS_WINO) + (size_t)li * DINO * D);
                const bool split = (half == 0 && !even);
                const int Mg = split ? SEQ : M;
                pg8::Gemm g{HM, Wt, Mg, N, D}; pg8::StaticOrder S; S.init(Mg, N, G, bx);
                EpiBf E{R1, N, half == 1 ? 2 : (even ? 0 : 1), half == 1 ? l : li, P.out};
                pg8::gemm_phase<EpiBf, pg8::StaticOrder, true, true>(lds, g, S, E);
                if (split) { PHASE_IDS
                    float* outp = P.out; bf16* PR = R1;
                    small_gemm(HM + (size_t)SEQ * D, Wt, DINO, D, lds, bx, G, tid, lane, wave, [=](int sr, int c, float s0, float s1) {
                        const int b = sr >> 4, t = sr & 15;
                        *(unsigned*)(PR + (size_t)(SEQ + sr) * DINO + c) = pk2(s0, s1);
                        float* dst = nullptr;
                        if (c < 512) { if (t >= 1) dst = outp + O_POOLS + (((size_t)li * 16 + b) * 15 + (t - 1)) * 512 + c; }
                        else if (c >= 1536) dst = outp + O_VS + (((size_t)li * 16 + b) * 16 + t) * 512 + (c - 1536);
                        else if (c >= 1024) dst = outp + O_KS + (((size_t)li * 16 + b) * 16 + t) * 512 + (c - 1024);
                        if (dst) *(f32x2*)dst = (f32x2){s0, s1};
                    });
                }
            }
            xcd_barrier(xbar);
            if (half == 0) {
                if (even) {
                    { PHASE_IDS
                    kv_units_pipelined(R1, rope, KVS, bx, G, lds, tid, lane, wave);
                    sconv_items(P, li, R1, MIX, gtid, GT); }
                    xcd_barrier(xbar);
                    { PHASE_IDS for (int w = bx; w < 256; w += G) scan_task(KVS, P.out + O_RETP + (size_t)li * 32768, w, lds, tid); }
                    xcd_barrier(xbar);
                    { PHASE_IDS
                    retout_units_pipelined(P, li, R1, rope, KVS, MIX, bx, G, lds, tid, lane, wave);
                    for (int u = bx + ((1024 - bx + G - 1) / G) * G; u < 1024 + 128; u += G) retstep_unit(P, li, R1, rope, MIX, (u - 1024) >> 3, (u - 1024) & 7, lds, tid, lane, wave);
                    }
                } else {
                    { PHASE_IDS
                    const int nsplit = G > 128 ? 64 : 0;
                    if (bx < nsplit || nsplit == 0) for (int u = bx; u < 64; u += (nsplit ? nsplit : G)) attn_sample_unit3(P, li, R1, MIX, u >> 2, u & 3, lds, tid, lane, wave);
                    if (bx >= nsplit) for (int u = bx - nsplit; u < 1040; u += G - nsplit) pool_unit(P, li, R1, (const bf16*)(ws + WS_POOLW), MIX, u >> 2, u & 3, lds, tid, lane, wave);
                    for (int u = bx; u < 256; u += G) attn_prompt_unit2(P, li, R1, MIX, u >> 2, u & 3, lds, tid, lane, wave);
                    }
                }
            } else {
                { PHASE_IDS convgate_items(P, l, R1, ACT, gtid, GT); }
            }
            xcd_barrier(xbar);
            {
                const int K = half == 1 ? DFF : D;
                const bf16* A = half == 1 ? ACT : MIX;
                const bf16* Wt = half == 1 ? (const bf16*)(ws + WS_WDN) + (size_t)l * D * DFF
                                           : (even ? (const bf16*)(ws + WS_WOUTE) + (size_t)li * D * D : (const bf16*)(ws + WS_WOUTO) + (size_t)li * D * D);
                pg8::Gemm g{A, Wt, SEQ, D, K}; pg8::StaticOrder S; S.init(SEQ, D, G, bx);
                EpiRes E{xp, xs, X, modl + half * 3072 + 2048};
                pg8::gemm_phase<EpiRes, pg8::StaticOrder, true, true>(lds, g, S, E);
                { PHASE_IDS
                    const float* gate = modl + half * 3072 + 2048; float* Xs = X + (size_t)SEQ * D;
                    small_gemm(A + (size_t)SEQ * K, Wt, D, K, lds, bx, G, tid, lane, wave, [=](int sr, int c, float s0, float s1) {
                        const float* g2 = gate + (1 + (sr >> 4)) * MODW + c; const float* bp = xs + (size_t)sr * D + c;
                        *(f32x2*)(Xs + (size_t)sr * D + c) = (f32x2){bp[0] + g2[0] * s0, bp[1] + g2[1] * s1};
                    });
                }
            }
            xcd_barrier(xbar);
        }
    }
    { PHASE_IDS final_norm_phase(X, P.in[I_NFIN], gw, NGW, lane); }
}

extern "C" void kernel_launch(void* const* d_in, const int* in_sizes, int n_in, void* d_out, int out_size, void* d_ws, size_t ws_size, hipStream_t stream) {
    static int grid = 0;
    if (grid == 0) {
        if (n_in != 27 || (size_t)out_size != O_END || ws_size < WS_END) { fprintf(stderr, "kernel_launch: unexpected shapes: n_in %d out %d ws %zu (need %zu)\n", n_in, out_size, ws_size, (size_t)WS_END); grid = -1; return; }
        int dev = 0, cus = 0, per_cu = 0;
        hipGetDevice(&dev); hipDeviceGetAttribute(&cus, hipDeviceAttributeMultiprocessorCount, dev);
        hipFuncSetAttribute((const void*)mega_fwd, hipFuncAttributeMaxDynamicSharedMemorySize, LDS_BYTES);
        hipOccupancyMaxActiveBlocksPerMultiprocessor(&per_cu, (const void*)mega_fwd, NTHR, LDS_BYTES);
        if (per_cu < 1) per_cu = 1;
        grid = cus;
        (void)hipGetLastError();
    }
    if (grid < 0) return;
    Params p{};
    for (int i = 0; i < 27; ++i) p.in[i] = (const float*)d_in[i];
    p.out = (float*)d_out; p.ws = (unsigned char*)d_ws;
    void* args[] = {&p};
    hipError_t e = hipLaunchCooperativeKernel((const void*)mega_fwd, dim3(grid), dim3(NTHR), args, LDS_BYTES, stream);
    if (e != hipSuccess) fprintf(stderr, "cooperative launch failed: %s (grid %d)\n", hipGetErrorString(e), grid);
}
```
